# Optimizing an MI355X kernel written in HIP

```python
import math
import jax
import jax.numpy as jnp
from jax import lax
import numpy as np

D_MODEL = 1024
BATCH = 2
SEQ = 16384
DEPTH = 2

ML_HEADS = 4
ML_DIM = 64
ML_WIDTH = ML_HEADS * ML_DIM
ML_CHUNK = 64
CONV_W = 4
DA_HEADS = 4
DA_QK_DIM = 32
DA_V_DIM = 2 * DA_QK_DIM
DA_WIDTH = DA_HEADS * DA_V_DIM
NSA_HEADS = 8
NSA_GROUPS = 2
NSA_REP = NSA_HEADS // NSA_GROUPS
NSA_DIM = 64
NSA_WIDTH = NSA_HEADS * NSA_DIM
NSA_KV = NSA_GROUPS * NSA_DIM
CMP_BLOCK = 32
CMP_STRIDE = 16
CMP_HIDDEN = 4 * NSA_DIM
SEL_BLOCK = 64
SEL_TOPK = 16
WINDOW = 512
Q_BLOCK = 128
D_MIX = ML_WIDTH + DA_WIDTH + NSA_WIDTH
D_FF = 4 * D_MODEL
EPS = 1e-6
FORCE_SCORE = 1e4
IN_SIZES = (ML_WIDTH, ML_WIDTH, ML_WIDTH, ML_WIDTH, ML_HEADS, ML_HEADS,
            2 * DA_HEADS * DA_QK_DIM, 2 * DA_HEADS * DA_QK_DIM, DA_WIDTH,
            NSA_WIDTH, NSA_KV, NSA_KV, NSA_KV, NSA_KV, NSA_KV, NSA_KV, 3 * NSA_HEADS)
IN_COLS = sum(IN_SIZES)

kernel_name = 'hybrid_mlstm_diffattn_nsa_block'

F32 = jnp.float32


def rmsnorm(x, g):
    xf = x.astype(F32)
    y = xf * lax.rsqrt(jnp.mean(xf * xf, axis=-1, keepdims=True) + EPS)
    return (y * g).astype(x.dtype)


def head_rmsnorm(x, g, heads):
    B, S, W = x.shape
    xf = x.astype(F32).reshape(B, S, heads, W // heads)
    y = xf * lax.rsqrt(jnp.mean(xf * xf, axis=-1, keepdims=True) + EPS)
    return y.reshape(B, S, W) * g


def masked_softmax(s, mask):
    s = jnp.where(mask, s.astype(F32), -jnp.inf)
    m = jnp.max(s, axis=-1, keepdims=True)
    m = jnp.where(jnp.isfinite(m), m, 0.0)
    p = jnp.exp(s - m)
    den = jnp.sum(p, axis=-1, keepdims=True)
    return p / jnp.where(den > 0, den, 1.0)


def causal_dwconv(x, w):
    return lax.conv_general_dilated(
        x, w[:, None, :].astype(x.dtype), window_strides=(1,), padding=[(CONV_W - 1, 0)],
        dimension_numbers=('NWC', 'WIO', 'NWC'), feature_group_count=x.shape[-1])


def mlstm(q, k, v, i_pre, f_pre):
    B, S, H, d = q.shape
    L = ML_CHUNK
    NC = S // L

    def chunk(t):
        return t.astype(F32).reshape(B, NC, L, H, -1).transpose(0, 3, 1, 2, 4)

    q = chunk(q)
    k = chunk(k) * (d ** -0.5)
    v = chunk(v)
    ig = i_pre.astype(F32).reshape(B, NC, L, H).transpose(0, 3, 1, 2)
    logf = jax.nn.log_sigmoid(f_pre.astype(F32)).reshape(B, NC, L, H).transpose(0, 3, 1, 2)
    b = jnp.cumsum(logf, axis=-1)
    g = b[..., -1]
    a = g[..., None] - b + ig
    a_max = jnp.max(a, axis=-1)
    w = jnp.exp(a - a_max[..., None])
    c_loc = jnp.einsum('bhcl,bhclv,bhclk->bhcvk', w, v, k)
    n_loc = jnp.einsum('bhcl,bhclk->bhck', w, k)

    def step(carry, xs):
        C, n, m = carry
        gc, amc, Cl, nl = xs
        m_new = jnp.maximum(gc + m, amc)
        s_prev = jnp.exp(gc + m - m_new)
        s_loc = jnp.exp(amc - m_new)
        C_new = s_prev[..., None, None] * C + s_loc[..., None, None] * Cl
        n_new = s_prev[..., None] * n + s_loc[..., None] * nl
        return (C_new, n_new, m_new), (C, n, m)

    init = (jnp.zeros((B, H, d, d), F32), jnp.zeros((B, H, d), F32), jnp.zeros((B, H), F32))
    xs = (jnp.moveaxis(g, 2, 0), jnp.moveaxis(a_max, 2, 0),
          jnp.moveaxis(c_loc, 2, 0), jnp.moveaxis(n_loc, 2, 0))
    _, (C_prev, n_prev, m_prev) = lax.scan(step, init, xs)
    C_prev = jnp.moveaxis(C_prev, 0, 2)
    n_prev = jnp.moveaxis(n_prev, 0, 2)
    m_prev = jnp.moveaxis(m_prev, 0, 2)

    causal = jnp.tril(jnp.ones((L, L), dtype=bool))
    D = jnp.where(causal, b[..., :, None] - b[..., None, :] + ig[..., None, :], -jnp.inf)
    inter_log = b + m_prev[..., None]
    m_t = jnp.maximum(inter_log, jnp.max(D, axis=-1))
    wts = jnp.exp(D - m_t[..., None]) * jnp.einsum('bhctd,bhcsd->bhcts', q, k)
    s_inter = jnp.exp(inter_log - m_t)
    num = (jnp.einsum('bhcts,bhcsv->bhctv', wts, v)
           + s_inter[..., None] * jnp.einsum('bhcvk,bhctk->bhctv', C_prev, q))
    den = jnp.sum(wts, axis=-1) + s_inter * jnp.einsum('bhck,bhctk->bhct', n_prev, q)
    h = num / jnp.maximum(jnp.abs(den), jnp.exp(-m_t))[..., None]
    return h.transpose(0, 2, 3, 1, 4).reshape(B, S, H * d)


def diff_attention(q, k, v, lam, lam_init, gain):
    B, S, _ = q.shape
    H, d = DA_HEADS, DA_QK_DIM
    q = q.reshape(B, S, H, 2, d).transpose(0, 2, 3, 1, 4) * (d ** -0.5)
    k = k.reshape(B, S, H, 2, d).transpose(0, 2, 3, 1, 4)
    v = v.reshape(B, S, H, DA_V_DIM).transpose(0, 2, 1, 3)
    kpos = jnp.arange(S)

    def block(qb):
        q0 = qb * Q_BLOCK
        qblk = lax.dynamic_slice_in_dim(q, q0, Q_BLOCK, axis=3)
        s = jnp.einsum('bhmqd,bhmkd->bhmqk', qblk, k, preferred_element_type=F32)
        qpos = q0 + jnp.arange(Q_BLOCK)
        s = jnp.where(kpos[None, :] <= qpos[:, None], s, -jnp.inf)
        p = jax.nn.softmax(s, axis=-1)
        att = p[:, :, 0] - lam * p[:, :, 1]
        return jnp.einsum('bhqk,bhkv->bhqv', att, v.astype(F32))

    o = lax.map(block, jnp.arange(S // Q_BLOCK))
    o = o.transpose(1, 0, 3, 2, 4).reshape(B, S, DA_WIDTH)
    return head_rmsnorm(o, gain, DA_HEADS) * (1.0 - lam_init)


def nsa_attention(q, kc_raw, vc_raw, ks_raw, vs_raw, kw_raw, vw_raw, gate_pre, pe, w1, w2):
    B, S, _ = q.shape
    G, R, d = NSA_GROUPS, NSA_REP, NSA_DIM
    q = q.reshape(B, S, G, R, d).transpose(0, 2, 3, 1, 4) * (d ** -0.5)
    gates = jax.nn.sigmoid(gate_pre.reshape(B, S, G, R, 3).transpose(0, 2, 3, 1, 4))

    def to_g(t):
        return t.reshape(B, S, G, d).transpose(0, 2, 1, 3)

    ncb = (S - CMP_BLOCK) // CMP_STRIDE + 1
    tok = (jnp.arange(ncb) * CMP_STRIDE)[:, None] + jnp.arange(CMP_BLOCK)[None, :]

    def compress(t, pe_, w1_, w2_):
        blk = to_g(t)[:, :, tok] + pe_
        hid = jax.nn.gelu(blk.reshape(B, G, ncb, CMP_BLOCK * d) @ w1_)
        return hid @ w2_

    k_cmp = compress(kc_raw, pe[0], w1[0], w2[0])
    v_cmp = compress(vc_raw, pe[1], w1[1], w2[1])
    cmp_end = jnp.arange(ncb) * CMP_STRIDE + CMP_BLOCK - 1

    nsb = S // SEL_BLOCK
    n_sel = min(SEL_TOPK, nsb)
    k_sel = to_g(ks_raw).reshape(B, G, nsb, SEL_BLOCK, d)
    v_sel = to_g(vs_raw).reshape(B, G, nsb, SEL_BLOCK, d)
    ratio = SEL_BLOCK // CMP_STRIDE
    lead = CMP_BLOCK // CMP_STRIDE - 1
    blk_ids = jnp.arange(nsb)
    bi = jnp.arange(B)[:, None, None, None]
    gi = jnp.arange(G)[None, :, None, None]

    pad = ((0, 0), (0, 0), (WINDOW, 0), (0, 0))
    k_win = jnp.pad(to_g(kw_raw), pad)
    v_win = jnp.pad(to_g(vw_raw), pad)

    def block(qb):
        q0 = qb * Q_BLOCK
        qblk = lax.dynamic_slice_in_dim(q, q0, Q_BLOCK, axis=3)
        gblk = lax.dynamic_slice_in_dim(gates, q0, Q_BLOCK, axis=3)
        qpos = q0 + jnp.arange(Q_BLOCK)

        s = jnp.einsum('bgrqd,bgcd->bgrqc', qblk, k_cmp, preferred_element_type=F32)
        p_cmp = masked_softmax(s, cmp_end[None, :] <= qpos[:, None])
        o_cmp = jnp.einsum('bgrqc,bgcd->bgrqd', p_cmp, v_cmp.astype(F32))

        imp = jnp.pad(jnp.sum(p_cmp, axis=2), ((0, 0), (0, 0), (0, 0), (lead, ratio + lead)))
        p_slc = jnp.zeros((B, G, Q_BLOCK, nsb), F32)
        for o in range(-lead, ratio):
            st = lead + o
            p_slc = p_slc + imp[..., st:st + ratio * nsb:ratio]
        cur = qpos // SEL_BLOCK
        forced = ((blk_ids[None, :] == 0) | (blk_ids[None, :] == cur[:, None])
                  | (blk_ids[None, :] == cur[:, None] - 1))
        causal_blk = blk_ids[None, :] * SEL_BLOCK <= qpos[:, None]
        score = jnp.where(forced, FORCE_SCORE, jnp.where(causal_blk, p_slc, -1.0))
        _, idx = lax.top_k(score, n_sel)
        ksb = k_sel[bi, gi, idx]
        vsb = v_sel[bi, gi, idx]
        pos = idx[..., None] * SEL_BLOCK + jnp.arange(SEL_BLOCK)
        smask = (pos <= qpos[:, None, None]).reshape(B, G, 1, Q_BLOCK, n_sel * SEL_BLOCK)
        s = jnp.einsum('bgrqd,bgqnld->bgrqnl', qblk, ksb, preferred_element_type=F32)
        p = masked_softmax(s.reshape(B, G, R, Q_BLOCK, n_sel * SEL_BLOCK), smask)
        o_sel = jnp.einsum('bgrqm,bgqmd->bgrqd', p,
                           vsb.reshape(B, G, Q_BLOCK, n_sel * SEL_BLOCK, d).astype(F32))

        kwb = lax.dynamic_slice_in_dim(k_win, q0, Q_BLOCK + WINDOW, axis=2)
        vwb = lax.dynamic_slice_in_dim(v_win, q0, Q_BLOCK + WINDOW, axis=2)
        wpos = q0 - WINDOW + jnp.arange(Q_BLOCK + WINDOW)
        rel = qpos[:, None] - wpos[None, :]
        wmask = (rel >= 0) & (rel < WINDOW) & (wpos[None, :] >= 0)
        s = jnp.einsum('bgrqd,bgkd->bgrqk', qblk, kwb, preferred_element_type=F32)
        o_win = jnp.einsum('bgrqk,bgkd->bgrqd', masked_softmax(s, wmask), vwb.astype(F32))

        gf = gblk.astype(F32)
        return gf[..., 0:1] * o_cmp + gf[..., 1:2] * o_sel + gf[..., 2:3] * o_win

    o = lax.map(block, jnp.arange(S // Q_BLOCK))
    return o.transpose(1, 0, 4, 2, 3, 5).reshape(B, S, NSA_WIDTH)


def token_mixer(h, layer_idx, w_in, ml_conv, ml_gate_bias, ml_norm, da_lambda, da_norm,
                nsa_pe, nsa_w1, nsa_w2, w_out):
    B, S, _ = h.shape
    z = h @ w_in
    splits = [int(c) for c in np.cumsum(IN_SIZES)[:-1]]
    (ml_q, ml_k, ml_v, ml_o, ml_i, ml_f, da_q, da_k, da_v,
     ns_q, ns_kc, ns_vc, ns_ks, ns_vs, ns_kw, ns_vw, ns_g) = jnp.split(z, splits, axis=-1)

    qk = jax.nn.silu(causal_dwconv(jnp.concatenate([ml_q, ml_k], axis=-1), ml_conv))
    ml_q, ml_k = jnp.split(qk, 2, axis=-1)
    i_pre = ml_i + ml_gate_bias[:ML_HEADS]
    f_pre = ml_f + ml_gate_bias[ML_HEADS:]
    hd = (B, S, ML_HEADS, ML_DIM)
    y_ml = mlstm(ml_q.reshape(hd), ml_k.reshape(hd), ml_v.reshape(hd), i_pre, f_pre)
    y_ml = head_rmsnorm(jax.nn.sigmoid(ml_o.astype(F32)) * y_ml, ml_norm, ML_HEADS)

    lam_init = 0.8 - 0.6 * math.exp(-0.3 * layer_idx)
    lf = da_lambda.astype(F32)
    lam = jnp.exp(jnp.sum(lf[0] * lf[1])) - jnp.exp(jnp.sum(lf[2] * lf[3])) + lam_init
    y_da = diff_attention(da_q, da_k, da_v, lam, lam_init, da_norm)

    y_ns = nsa_attention(ns_q, ns_kc, ns_vc, ns_ks, ns_vs, ns_kw, ns_vw, ns_g, nsa_pe, nsa_w1, nsa_w2)

    mixed = jnp.concatenate([y_ml.astype(h.dtype), y_da.astype(h.dtype), y_ns.astype(h.dtype)], axis=-1)
    return mixed @ w_out


def squared_relu_mlp(h, w1, w2):
    return jnp.square(jax.nn.relu(h @ w1)) @ w2


def setup_inputs(seed: int = 0) -> dict:
    key = jax.random.key(seed)
    ks = jax.random.split(key, 18)

    def nrm(k, shape, scale):
        return jax.random.normal(k, shape, F32) * scale

    x = nrm(ks[0], (BATCH, SEQ, D_MODEL), 1.0)
    norm1 = 1.0 + nrm(ks[1], (DEPTH, D_MODEL), 0.02)
    w_in = nrm(ks[2], (DEPTH, D_MODEL, IN_COLS), D_MODEL ** -0.5)
    ml_conv = nrm(ks[3], (DEPTH, CONV_W, 2 * ML_WIDTH), CONV_W ** -0.5)
    ig_bias = nrm(ks[4], (DEPTH, ML_HEADS), 0.1)
    fg_bias = jnp.linspace(3.0, 6.0, ML_HEADS, dtype=F32)[None, :] + nrm(ks[5], (DEPTH, ML_HEADS), 0.01)
    ml_gate_bias = jnp.concatenate([ig_bias, fg_bias], axis=-1)
    ml_norm = 1.0 + nrm(ks[6], (DEPTH, ML_WIDTH), 0.02)
    da_lambda = nrm(ks[7], (DEPTH, 4, DA_QK_DIM), 0.1)
    da_norm = 1.0 + nrm(ks[8], (DEPTH, DA_WIDTH), 0.02)
    nsa_pe = nrm(ks[9], (DEPTH, 2, CMP_BLOCK, NSA_DIM), 0.1)
    nsa_w1 = nrm(ks[10], (DEPTH, 2, CMP_BLOCK * NSA_DIM, CMP_HIDDEN), (CMP_BLOCK * NSA_DIM) ** -0.5)
    nsa_w2 = nrm(ks[11], (DEPTH, 2, CMP_HIDDEN, NSA_DIM), CMP_HIDDEN ** -0.5)
    w_out = nrm(ks[12], (DEPTH, D_MIX, D_MODEL), D_MIX ** -0.5)
    norm2 = 1.0 + nrm(ks[13], (DEPTH, D_MODEL), 0.02)
    w_ff1 = nrm(ks[14], (DEPTH, D_MODEL, D_FF), D_MODEL ** -0.5)
    w_ff2 = nrm(ks[15], (DEPTH, D_FF, D_MODEL), D_FF ** -0.5)
    final_norm = 1.0 + nrm(ks[16], (D_MODEL,), 0.02)
    return {'x': x, 'norm1': norm1, 'w_in': w_in, 'ml_conv': ml_conv, 'ml_gate_bias': ml_gate_bias,
            'ml_norm': ml_norm, 'da_lambda': da_lambda, 'da_norm': da_norm, 'nsa_pe': nsa_pe,
            'nsa_w1': nsa_w1, 'nsa_w2': nsa_w2, 'w_out': w_out, 'norm2': norm2,
            'w_ff1': w_ff1, 'w_ff2': w_ff2, 'final_norm': final_norm}


def reference(x, norm1, w_in, ml_conv, ml_gate_bias, ml_norm, da_lambda, da_norm, nsa_pe,
              nsa_w1, nsa_w2, w_out, norm2, w_ff1, w_ff2, final_norm):
    for l in range(DEPTH):
        h = rmsnorm(x, norm1[l])
        x = x + token_mixer(h, l, w_in[l], ml_conv[l], ml_gate_bias[l], ml_norm[l], da_lambda[l],
                            da_norm[l], nsa_pe[l], nsa_w1[l], nsa_w2[l], w_out[l])
        x = x + squared_relu_mlp(rmsnorm(x, norm2[l]), w_ff1[l], w_ff2[l])
    return rmsnorm(x, final_norm)
```

```cpp
#include <hip/hip_runtime.h>
#include <hip/hip_cooperative_groups.h>
#include <cstdio>
#include <cstdint>
namespace cg = cooperative_groups;
namespace pg8 {
#define PG8_LAS __attribute__((address_space(3)))
typedef unsigned short bf16_t;
typedef short bf16x8 __attribute__((ext_vector_type(8)));
typedef float f32x4 __attribute__((ext_vector_type(4)));
typedef unsigned u32x4 __attribute__((ext_vector_type(4)));
constexpr int BM = 256, BK = 64, HALF = 128, HTB = HALF * BK * 2  , STAGE_BYTES = 8 * HTB, NXCD = 8, WGM = 8;

__host__ __device__ __forceinline__ int lds_byte(int r, int c) { const int st = (r >> 4) * 2 + (c >> 5), rr = r & 15, cc = c & 31, ob = rr * 64 + cc * 2; return st * 1024 + (ob ^ (((ob >> 9) & 1) << 5)); }
__host__ __device__ __forceinline__ void stage_rc(int b, int& R, int& C) { const int st = b / 1024, sb = b % 1024, swz = sb ^ (((sb >> 9) & 1) << 5); R = (st >> 1) * 16 + swz / 64; C = (st & 1) * 32 + (swz % 64) / 2; }
__host__ __device__ __forceinline__ int perm32(int rho) { const int n = rho >> 4, i = rho & 15; return 8 * (i >> 2) + 4 * n + (i & 3); }

struct Unit { int pm, pn; };
struct Gemm { const bf16_t* A; const bf16_t* Bt; int M, N, K; };

struct StaticOrder {
    int nM, nN, nwg, G, c;
    __host__ __device__ void init(int M, int N, int G_, int c_) { nM = M / BM; nN = N / BM; nwg = nM * nN; G = G_; c = c_; }
    __host__ __device__ bool next(int i, Unit& u) const {
        const long L = (long)i * G + c; if (L >= nwg) return false;
        int wgid = (int)L; { const int q = nwg / NXCD, r = nwg % NXCD, xcd = wgid % NXCD, off = wgid / NXCD; wgid = (xcd < r ? xcd * (q + 1) : r * (q + 1) + (xcd - r) * q) + off; }
        const int nig = WGM * nN, gid = wgid / nig, fm = gid * WGM, gsz = (nM - fm) < WGM ? (nM - fm) : WGM;
        u.pm = fm + ((wgid % nig) % gsz); u.pn = (wgid % nig) / gsz; return true;
    }
    __device__ __forceinline__ void a_ready(const Unit&) const {}
    __device__ __forceinline__ void done(const Unit&) const {}
};

__device__ __forceinline__ unsigned cvt_pk_bf16(float lo, float hi) { unsigned r; asm volatile("v_cvt_pk_bf16_f32 %0, %1, %2" : "=v"(r) : "v"(lo), "v"(hi)); return r; }
template <class Epi, class Sched, bool ALIGN_EPI = false, bool SP2 = false>
__device__ __forceinline__ void gemm_phase(PG8_LAS unsigned char* lds, const Gemm g, const Sched& S, const Epi& E) {
    int tid = threadIdx.x; asm volatile("" : "+v"(tid)); const int wid = __builtin_amdgcn_readfirstlane(tid >> 6), lane = tid & 63, wr = wid >> 2, wc = wid & 3, fr = lane & 15, fq = lane >> 4;
    const int K = g.K, nt = K / BK;
    unsigned voffA[2], voffB[2];
#pragma unroll
    for (int i = 0; i < 2; ++i) { int R, C; stage_rc(tid * 16 + i * 8192, R, C); const int Rb = Epi::PERM ? ((R & ~31) + perm32(R & 31)) : R;
        voffA[i] = (unsigned)(R * K + C) * 2u; voffB[i] = (unsigned)(Rb * K + C) * 2u; }
    const size_t kstep = (size_t)(BK * 2);
    const size_t hstep = (size_t)HALF * K * 2;
    const size_t tstep = 2 * hstep;
    const unsigned ldsw = (unsigned)wid * 1024u;
    const int aoff = lds_byte(wr * 64 + fr, fq * 8), boff = lds_byte(wc * 32 + fr, fq * 8);
#define PG8_SA(b, h) (((b) * 2 + (h)) * HTB)
#define PG8_SB(b, h) ((4 + (b) * 2 + (h)) * HTB)
#define PG8_STAGE(bufoff, gbase, voff) do { _Pragma("unroll") for (int _i = 0; _i < 2; ++_i) \
        __builtin_amdgcn_global_load_lds((const unsigned*)((const char*)(gbase) + (voff)[_i]), (PG8_LAS unsigned*)(lds + (bufoff) + ldsw + _i * 8192), 16, 0, 0); } while (0)
#define PG8_LDA(dst, b, h) do { _Pragma("unroll") for (int m = 0; m < 4; ++m) _Pragma("unroll") for (int k = 0; k < 2; ++k) dst[m][k] = *(const PG8_LAS bf16x8*)(lds + PG8_SA(b, h) + aoff + m * 2048 + k * 1024); } while (0)
#define PG8_LDB(dst, b, h) do { _Pragma("unroll") for (int n = 0; n < 2; ++n) _Pragma("unroll") for (int k = 0; k < 2; ++k) dst[n][k] = *(const PG8_LAS bf16x8*)(lds + PG8_SB(b, h) + boff + n * 2048 + k * 1024); } while (0)
#define PG8_MMA(ai, bj, At, Bt) do { __builtin_amdgcn_s_setprio(1); _Pragma("unroll") for (int m = 0; m < 4; ++m) _Pragma("unroll") for (int n = 0; n < 2; ++n) _Pragma("unroll") for (int k = 0; k < 2; ++k) \
        acc[ai][bj][m][n] = __builtin_amdgcn_mfma_f32_16x16x32_bf16(Bt[n][k], At[m][k], acc[ai][bj][m][n], 0, 0, 0); __builtin_amdgcn_s_setprio(0); } while (0)
#define PG8_WAIT_V(n) asm volatile("s_waitcnt vmcnt(" #n ")" ::: "memory")
#define PG8_WAIT_L(n) asm volatile("s_waitcnt lgkmcnt(" #n ")" ::: "memory")
#define PG8_BAR __builtin_amdgcn_s_barrier()
#define PG8_SCHED __builtin_amdgcn_sched_barrier(0)
    Unit cur, nxt; int ui = 0;
    if (!S.next(0, cur)) return;
    f32x4 acc[2][2][4][2];
#pragma unroll
    for (int a = 0; a < 2; ++a)
#pragma unroll
        for (int b = 0; b < 2; ++b)
#pragma unroll
            for (int m = 0; m < 4; ++m)
#pragma unroll
                for (int n = 0; n < 2; ++n) acc[a][b][m][n] = (f32x4){0.f, 0.f, 0.f, 0.f};
    bf16x8 At[4][2], B0[2][2], B1[2][2];
    const char* cA = (const char*)g.A + (size_t)cur.pm * tstep; const char* cB = (const char*)g.Bt + (size_t)cur.pn * tstep;
    S.a_ready(cur);
    if constexpr (SP2) {
        PG8_STAGE(PG8_SB(0, 0), cB, voffB); PG8_STAGE(PG8_SB(0, 1), cB + hstep, voffB); PG8_STAGE(PG8_SA(0, 0), cA, voffA); PG8_STAGE(PG8_SA(0, 1), cA + hstep, voffA);
        if (wr == 1) PG8_BAR;
        PG8_WAIT_V(2); PG8_BAR;
        PG8_STAGE(PG8_SB(1, 0), cB + kstep, voffB); PG8_STAGE(PG8_SA(1, 0), cA + kstep, voffA); PG8_STAGE(PG8_SB(1, 1), cB + hstep + kstep, voffB);
        PG8_WAIT_V(6); PG8_BAR;
    } else {
        PG8_STAGE(PG8_SB(0, 0), cB, voffB); PG8_STAGE(PG8_SA(0, 0), cA, voffA); PG8_STAGE(PG8_SB(0, 1), cB + hstep, voffB); PG8_STAGE(PG8_SA(0, 1), cA + hstep, voffA);
        if (wr == 1) PG8_BAR;
        PG8_WAIT_V(4); PG8_BAR;
        PG8_STAGE(PG8_SB(1, 0), cB + kstep, voffB); PG8_STAGE(PG8_SA(1, 0), cA + kstep, voffA); PG8_STAGE(PG8_SB(1, 1), cB + hstep + kstep, voffB);
        PG8_WAIT_V(6); PG8_BAR;
    }
    for (;;) {
        const bool has_next = S.next(ui + 1, nxt);
        const char* nA = has_next ? (const char*)g.A + (size_t)nxt.pm * tstep : cA; const char* nB = has_next ? (const char*)g.Bt + (size_t)nxt.pn * tstep : cB;
        for (int t = 0; t < nt; t += 2) {
            const bool last = (t == nt - 2);
            const char* a1 = cA + (size_t)(t + 1) * kstep;
            const char* a2 = last ? nA : cA + (size_t)(t + 2) * kstep; const char* b2 = last ? nB : cB + (size_t)(t + 2) * kstep;
            const char* a3 = a2 + kstep; const char* b3 = b2 + kstep;
            if (last && has_next) S.a_ready(nxt);
            if constexpr (SP2) {
            PG8_LDB(B0, 0, 0); PG8_LDB(B1, 0, 1); PG8_SCHED; PG8_LDA(At, 0, 0); PG8_STAGE(PG8_SA(1, 1), a1 + hstep, voffA);
            PG8_WAIT_V(8); PG8_WAIT_L(0); PG8_BAR; PG8_MMA(0, 0, At, B0); PG8_MMA(0, 1, At, B1); PG8_BAR; PG8_SCHED;
            PG8_LDA(At, 0, 1); PG8_STAGE(PG8_SB(0, 0), b2, voffB); PG8_STAGE(PG8_SB(0, 1), b2 + hstep, voffB); PG8_STAGE(PG8_SA(0, 0), a2, voffA);
            PG8_WAIT_V(8); PG8_WAIT_L(0); PG8_BAR; PG8_MMA(1, 0, At, B0); PG8_MMA(1, 1, At, B1); PG8_BAR; PG8_SCHED;
            PG8_LDB(B0, 1, 0); PG8_LDB(B1, 1, 1); PG8_SCHED; PG8_LDA(At, 1, 0); PG8_STAGE(PG8_SA(0, 1), a2 + hstep, voffA);
            PG8_WAIT_V(8); PG8_WAIT_L(0); PG8_BAR; PG8_MMA(0, 0, At, B0); PG8_MMA(0, 1, At, B1); PG8_BAR; PG8_SCHED;
            PG8_LDA(At, 1, 1); PG8_STAGE(PG8_SB(1, 0), b3, voffB); PG8_STAGE(PG8_SB(1, 1), b3 + hstep, voffB); PG8_STAGE(PG8_SA(1, 0), a3, voffA);
            PG8_WAIT_V(8); PG8_WAIT_L(0); PG8_BAR; PG8_MMA(1, 0, At, B0); PG8_MMA(1, 1, At, B1); PG8_BAR; PG8_SCHED;
            } else {
            PG8_LDB(B0, 0, 0); PG8_SCHED; PG8_LDA(At, 0, 0); PG8_STAGE(PG8_SA(1, 1), a1 + hstep, voffA);
            PG8_WAIT_L(8); PG8_BAR; PG8_WAIT_L(0); PG8_MMA(0, 0, At, B0); PG8_BAR; PG8_SCHED;
            PG8_LDB(B1, 0, 1); PG8_STAGE(PG8_SB(0, 0), b2, voffB);
            PG8_BAR; PG8_WAIT_L(0); PG8_MMA(0, 1, At, B1); PG8_BAR;
            PG8_LDA(At, 0, 1); PG8_STAGE(PG8_SA(0, 0), a2, voffA);
            PG8_BAR; PG8_WAIT_L(0); PG8_MMA(1, 0, At, B0); PG8_BAR; PG8_SCHED;
            PG8_STAGE(PG8_SB(0, 1), b2 + hstep, voffB);
            PG8_WAIT_V(6); PG8_BAR; PG8_MMA(1, 1, At, B1); PG8_BAR;
            PG8_LDB(B0, 1, 0); PG8_SCHED; PG8_LDA(At, 1, 0); PG8_STAGE(PG8_SA(0, 1), a2 + hstep, voffA);
            PG8_WAIT_L(8); PG8_BAR; PG8_WAIT_L(0); PG8_MMA(0, 0, At, B0); PG8_BAR; PG8_SCHED;
            PG8_LDB(B1, 1, 1); PG8_STAGE(PG8_SB(1, 0), b3, voffB);
            PG8_BAR; PG8_WAIT_L(0); PG8_MMA(0, 1, At, B1); PG8_BAR;
            PG8_LDA(At, 1, 1); PG8_STAGE(PG8_SA(1, 0), a3, voffA);
            PG8_BAR; PG8_WAIT_L(0); PG8_MMA(1, 0, At, B0); PG8_BAR; PG8_SCHED;
            PG8_STAGE(PG8_SB(1, 1), b3 + hstep, voffB);
            PG8_WAIT_V(6); PG8_BAR; PG8_MMA(1, 1, At, B1); PG8_BAR;
            }
        }
        if constexpr (ALIGN_EPI) { if (wr == 0) PG8_BAR; }
        if constexpr (!Epi::AFTER_DRAIN) { E(acc, cur, wr, wc, fr, fq); S.done(cur); }
        if (!has_next) break;
#pragma unroll
        for (int a = 0; a < 2; ++a)
#pragma unroll
            for (int b = 0; b < 2; ++b)
#pragma unroll
                for (int m = 0; m < 4; ++m)
#pragma unroll
                    for (int n = 0; n < 2; ++n) acc[a][b][m][n] = (f32x4){0.f, 0.f, 0.f, 0.f};
        cur = nxt; cA = nA; cB = nB; ++ui;
        if constexpr (ALIGN_EPI) { if (wr == 1) PG8_BAR; }
    }
    PG8_WAIT_V(0);
    if constexpr (!ALIGN_EPI) { if (wr == 0) PG8_BAR; }
    PG8_BAR;
    if constexpr (Epi::AFTER_DRAIN) { E.fused(acc, cur, wr, wc, fr, fq, lds, wid, lane); S.done(cur); }
#undef PG8_SA
#undef PG8_SB
#undef PG8_STAGE
#undef PG8_LDA
#undef PG8_LDB
#undef PG8_MMA
#undef PG8_WAIT_V
#undef PG8_WAIT_L
#undef PG8_BAR
#undef PG8_SCHED
}
}
#ifndef REP_CMP
#define REP_CMP 1
#endif
#ifndef REP_SYNC
#define REP_SYNC 1
#endif
#ifndef REP_PRO
#define REP_PRO 1
#endif
#ifndef REP_NORM
#define REP_NORM 1
#endif
#ifndef REP_GEMM
#define REP_GEMM 1
#endif
#ifndef REP_MLL
#define REP_MLL 1
#endif
#ifndef REP_CMPRS
#define REP_CMPRS 1
#endif
#ifndef REP_VST
#define REP_VST 1
#endif
#ifndef REP_DA
#define REP_DA 1
#endif
#ifndef REP_WIN
#define REP_WIN 1
#endif
#ifndef REP_MLO
#define REP_MLO 1
#endif
#ifndef REP_SEL
#define REP_SEL 1
#endif
#ifndef DBG_NOCMPACC
#define DBG_NOCMPACC 0
#endif
#ifndef DBG_SCRUB
#define DBG_SCRUB 0
#endif
#ifndef DBG_SCRUBKC
#define DBG_SCRUBKC 0
#endif
#ifndef DBG_SCRUBZ
#define DBG_SCRUBZ 0
#endif
#ifndef DBG_NOSEL
#define DBG_NOSEL 0
#endif
#ifndef DBG_MASK
#define DBG_MASK 31
#endif

#define LAS __attribute__((address_space(3)))
typedef unsigned short bf16_t;
typedef short bf16x8 __attribute__((ext_vector_type(8)));
typedef short bf16x4 __attribute__((ext_vector_type(4)));
typedef float f32x4 __attribute__((ext_vector_type(4)));
typedef float f32x16 __attribute__((ext_vector_type(16)));
typedef unsigned u32x4 __attribute__((ext_vector_type(4)));
typedef unsigned u32x2 __attribute__((ext_vector_type(2)));

constexpr int NB = 2, SEQ = 16384, NT = NB * SEQ, DM = 1024, ZLD = 3328, DFF = 4096, INC = 3104;
constexpr int C_MLQ = 0, C_MLK = 256, C_MLV = 512, C_MLO = 768, C_DAQ = 1024, C_DAK = 1280, C_DAV = 1536, C_NSQ = 1792,
              C_KC = 2304, C_VC = 2432, C_KS = 2560, C_VS = 2688, C_KW = 2816, C_VW = 2944;
constexpr float EPSN = 1e-6f, NEG = -1e30f, LOG2E = 1.4426950408889634f;
constexpr size_t MiB = 1u << 20;
constexpr size_t WS_ZU = 0;
constexpr size_t WS_ACCW = 208 * MiB;
constexpr size_t WS_HM = 256 * MiB;
constexpr size_t WS_CL = 320 * MiB;
constexpr size_t WS_ACC = 352 * MiB;
constexpr size_t WS_WIN = 416 * MiB;
constexpr size_t WS_WOUT = WS_WIN + 2 * (size_t)ZLD * 1024 * 2;
constexpr size_t WS_WF1 = WS_WOUT + 2 * (size_t)1024 * 1024 * 2;
constexpr size_t WS_WF2 = WS_WF1 + 2 * (size_t)4096 * 1024 * 2;
constexpr size_t WS_WC1 = WS_WF2 + 2 * (size_t)4096 * 1024 * 2;
constexpr size_t WS_WC2 = WS_WC1 + 4 * (size_t)256 * 2048 * 2;
constexpr size_t WS_G = 472 * MiB;
constexpr size_t WS_IDX = 476 * MiB;
constexpr size_t WS_VST = 480 * MiB;
constexpr size_t WS_KC = 488 * MiB;
constexpr size_t WS_NL = 489 * MiB;
constexpr size_t WS_GA = 490 * MiB;
constexpr size_t WS_MP = WS_GA + 65536;
constexpr size_t WS_CB = WS_MP + 65536;
constexpr size_t WS_QCTR = WS_CB + 8192;
constexpr size_t WS_SS1 = 492 * MiB;
constexpr size_t WS_SS2 = 494 * MiB;
constexpr size_t WS_BAR = 498 * MiB;
constexpr size_t WS_END = 499 * MiB;
static_assert(WS_WC2 + 4 * 64 * 256 * 2 <= WS_G, "ws map");

struct Params {
    const float* x; const float* norm1; const float* w_in; const float* ml_conv; const float* ml_gate_bias; const float* ml_norm;
    const float* da_lambda; const float* da_norm; const float* nsa_pe; const float* nsa_w1; const float* nsa_w2; const float* w_out;
    const float* norm2; const float* w_ff1; const float* w_ff2; const float* final_norm;
    float* out; unsigned char* ws;
    int ph_lo, ph_hi, coop, pad, bid, gdim;
};

__device__ __forceinline__ float bf2f(bf16_t v) { return __uint_as_float((unsigned)v << 16); }
typedef __bf16 bf16v2_t __attribute__((ext_vector_type(2)));
typedef float f32x2_t __attribute__((ext_vector_type(2)));
__device__ __forceinline__ unsigned pk2(float lo, float hi) { const f32x2_t v = {lo, hi}; const bf16v2_t b = __builtin_convertvector(v, bf16v2_t); return __builtin_bit_cast(unsigned, b); }
__device__ __forceinline__ bf16_t f2bf(float f) { return (bf16_t)(pk2(f, 0.f) & 0xffffu); }
__device__ __forceinline__ float ex2(float x) { return __builtin_amdgcn_exp2f(x); }
__device__ __forceinline__ float sigmoidf_(float x) { return 1.f / (1.f + __expf(-x)); }
__device__ __forceinline__ float wave_sum(float v) {
#pragma unroll
    for (int o = 1; o < 64; o <<= 1) v += __shfl_xor(v, o);
    return v;
}
__device__ __forceinline__ float wave_max(float v) {
#pragma unroll
    for (int o = 1; o < 64; o <<= 1) v = fmaxf(v, __shfl_xor(v, o));
    return v;
}
__device__ __forceinline__ float wave_incl_scan(float v, int lane) {
#pragma unroll
    for (int o = 1; o < 64; o <<= 1) { const float t = __shfl_up(v, o); if (lane >= o) v += t; }
    return v;
}
__device__ __forceinline__ float wave_incl_scanmax(float v, int lane) {
#pragma unroll
    for (int o = 1; o < 64; o <<= 1) { const float t = __shfl_up(v, o); if (lane >= o) v = fmaxf(v, t); }
    return v;
}
__device__ __forceinline__ float log_sigmoid(float x) { return fminf(x, 0.f) - log1pf(__expf(-fabsf(x))); }
__device__ __forceinline__ bf16x8 pack8(float a0, float a1, float a2, float a3, float a4, float a5, float a6, float a7) {
    u32x4 u; u.x = pk2(a0, a1); u.y = pk2(a2, a3); u.z = pk2(a4, a5); u.w = pk2(a6, a7); return __builtin_bit_cast(bf16x8, u);
}
__device__ __forceinline__ void unpack8(u32x4 v, float (&o)[8]) {
    o[0] = __uint_as_float(v.x << 16); o[1] = __uint_as_float(v.x & 0xffff0000u); o[2] = __uint_as_float(v.y << 16); o[3] = __uint_as_float(v.y & 0xffff0000u);
    o[4] = __uint_as_float(v.z << 16); o[5] = __uint_as_float(v.z & 0xffff0000u); o[6] = __uint_as_float(v.w << 16); o[7] = __uint_as_float(v.w & 0xffff0000u);
}
__device__ __forceinline__ int rowi32(int i, int h) { return (i & 3) + 8 * (i >> 2) + 4 * h; }

__device__ __forceinline__ float row_rstd(const float* SS, int row) {
    if (!SS) return 1.f;
    const f32x4* sp = (const f32x4*)(SS + (size_t)row * 16); const f32x4 a = sp[0], b = sp[1], c = sp[2], d = sp[3];
    const float t = ((a.x + a.y) + (a.z + a.w)) + ((b.x + b.y) + (b.z + b.w)) + ((c.x + c.y) + (c.z + c.w)) + ((d.x + d.y) + (d.z + d.w));
    return rsqrtf(t * (1.f / DM) + EPSN);
}
struct EpiIn {
    static constexpr bool PERM = true, AFTER_DRAIN = false;
    bf16_t* Z; float* G; const float* SS;
    __device__ __forceinline__ void operator()(const f32x4 (&acc)[2][2][4][2], const pg8::Unit& u, int wr, int wc, int fr, int fq) const {
        const int row0 = u.pm * 256 + wr * 64 + fr;
        if (u.pn < 12) {
            const int col0 = u.pn * 256 + wc * 32 + 8 * fq;
#pragma unroll
            for (int ai = 0; ai < 2; ++ai)
#pragma unroll
                for (int m = 0; m < 4; ++m) { const int row = row0 + ai * 128 + m * 16; const float rs = row_rstd(SS, row); bf16_t* rowp = Z + (size_t)row * ZLD + col0;
#pragma unroll
                    for (int bj = 0; bj < 2; ++bj) { const f32x4 v0 = acc[ai][bj][m][0] * rs, v1 = acc[ai][bj][m][1] * rs; u32x4 w;
                        w.x = pk2(v0[0], v0[1]); w.y = pk2(v0[2], v0[3]); w.z = pk2(v1[0], v1[1]); w.w = pk2(v1[2], v1[3]);
                        *(u32x4*)(rowp + bj * 128) = w; } }
        } else if (wc == 0) {
#pragma unroll
            for (int ai = 0; ai < 2; ++ai)
#pragma unroll
                for (int m = 0; m < 4; ++m) { const int row = row0 + ai * 128 + m * 16; const float rs = row_rstd(SS, row); float* gp = G + (size_t)row * 32 + 8 * fq;
                    *(f32x4*)gp = acc[ai][0][m][0] * rs; *(f32x4*)(gp + 4) = acc[ai][0][m][1] * rs; }
        }
    }
};
struct EpiRes {
    static constexpr bool PERM = false, AFTER_DRAIN = false;
    const float* base; float* out; const float* gain; bf16_t* XG; float* SS;
    __device__ __forceinline__ void operator()(const f32x4 (&acc)[2][2][4][2], const pg8::Unit& u, int wr, int wc, int fr, int fq) const {
        const int row0 = u.pm * 256 + wr * 64 + fr, col0 = u.pn * 256 + wc * 32 + 4 * fq;
        f32x4 g00 = {0.f, 0.f, 0.f, 0.f}, g01 = g00, g10 = g00, g11 = g00;
        if (XG) { g00 = *(const f32x4*)(gain + col0); g01 = *(const f32x4*)(gain + col0 + 16); g10 = *(const f32x4*)(gain + col0 + 128); g11 = *(const f32x4*)(gain + col0 + 144); }
#pragma unroll
        for (int ai = 0; ai < 2; ++ai)
#pragma unroll
            for (int m = 0; m < 4; ++m) { const int row = row0 + ai * 128 + m * 16; const size_t off = (size_t)row * DM + col0;
                const f32x4 b00 = *(const f32x4*)(base + off), b01 = *(const f32x4*)(base + off + 16), b10 = *(const f32x4*)(base + off + 128), b11 = *(const f32x4*)(base + off + 144);
                const f32x4 o00 = b00 + acc[ai][0][m][0], o01 = b01 + acc[ai][0][m][1], o10 = b10 + acc[ai][1][m][0], o11 = b11 + acc[ai][1][m][1];
                *(f32x4*)(out + off) = o00; *(f32x4*)(out + off + 16) = o01; *(f32x4*)(out + off + 128) = o10; *(f32x4*)(out + off + 144) = o11;
                if (XG) {
                    const f32x4 x00 = o00 * g00, x01 = o01 * g01, x10 = o10 * g10, x11 = o11 * g11; u32x2 w;
                    w.x = pk2(x00[0], x00[1]); w.y = pk2(x00[2], x00[3]); *(u32x2*)(XG + off) = w;
                    w.x = pk2(x01[0], x01[1]); w.y = pk2(x01[2], x01[3]); *(u32x2*)(XG + off + 16) = w;
                    w.x = pk2(x10[0], x10[1]); w.y = pk2(x10[2], x10[3]); *(u32x2*)(XG + off + 128) = w;
                    w.x = pk2(x11[0], x11[1]); w.y = pk2(x11[2], x11[3]); *(u32x2*)(XG + off + 144) = w;
                    const f32x4 q = o00 * o00 + o01 * o01 + o10 * o10 + o11 * o11;
                    float ss = (q[0] + q[1]) + (q[2] + q[3]);
                    ss += __shfl_xor(ss, 16); ss += __shfl_xor(ss, 32);
                    if (fq == 0) SS[(size_t)row * 16 + u.pn * 4 + wc] = ss;
                }
                asm volatile("" ::: "memory"); }
    }
};
struct EpiRelu2 {
    static constexpr bool PERM = true, AFTER_DRAIN = false;
    bf16_t* U; const float* SS;
    __device__ __forceinline__ void operator()(const f32x4 (&acc)[2][2][4][2], const pg8::Unit& u, int wr, int wc, int fr, int fq) const {
        const int row0 = u.pm * 256 + wr * 64 + fr, col0 = u.pn * 256 + wc * 32 + 8 * fq;
#pragma unroll
        for (int ai = 0; ai < 2; ++ai)
#pragma unroll
            for (int m = 0; m < 4; ++m) { const int row = row0 + ai * 128 + m * 16; const float rs = row_rstd(SS, row), rs2 = rs * rs; bf16_t* rowp = U + (size_t)row * DFF + col0;
#pragma unroll
                for (int bj = 0; bj < 2; ++bj) { f32x4 v0 = acc[ai][bj][m][0], v1 = acc[ai][bj][m][1];
#pragma unroll
                    for (int e = 0; e < 4; ++e) { const float a = fmaxf(v0[e], 0.f), b = fmaxf(v1[e], 0.f); v0[e] = a * a * rs2; v1[e] = b * b * rs2; }
                    u32x4 w; w.x = pk2(v0[0], v0[1]); w.y = pk2(v0[2], v0[3]); w.z = pk2(v1[0], v1[1]); w.w = pk2(v1[2], v1[3]);
                    *(u32x4*)(rowp + bj * 128) = w; } }
    }
};

__device__ __forceinline__ int map_in_col(int c) { return c < 1024 ? c : (c < 1032 ? 3072 + (c - 1024) : (c < 3080 ? c - 8 : c)); }
template <bool MAPIN>
__device__ __forceinline__ void transpose_item(const float* W, int K, int N, bf16_t* WT, LAS float* scr, int item, int lane) {
    const int nblk = N / 32, kb = item / nblk, nb = item % nblk, k0 = 64 * kb, n0 = 32 * nb;
#pragma unroll 8
    for (int i = 0; i < 32; ++i) { const int kk = 2 * i + (lane >> 5); scr[kk * 33 + (lane & 31)] = W[(size_t)(k0 + kk) * N + n0 + (lane & 31)]; }
    asm volatile("s_waitcnt lgkmcnt(0)" ::: "memory");
    const int c = lane & 7;
#pragma unroll
    for (int j = 0; j < 4; ++j) { const int n = (lane >> 3) + 8 * j; const LAS float* s = scr + (8 * c) * 33 + n;
        u32x4 o; o.x = pk2(s[0 * 33], s[1 * 33]); o.y = pk2(s[2 * 33], s[3 * 33]); o.z = pk2(s[4 * 33], s[5 * 33]); o.w = pk2(s[6 * 33], s[7 * 33]);
        const int dr = MAPIN ? map_in_col(n0 + n) : (n0 + n);
        *(u32x4*)(WT + (size_t)dr * K + k0 + 8 * c) = o; }
    asm volatile("s_waitcnt lgkmcnt(0)" ::: "memory");
}
__device__ __forceinline__ void rms_row_bf16(const float* xrow, const float* g, bf16_t* orow, int lane) {
    f32x4 v[4]; float s = 0.f;
#pragma unroll
    for (int j = 0; j < 4; ++j) { v[j] = ((const f32x4*)xrow)[lane + 64 * j]; s += (v[j].x * v[j].x + v[j].y * v[j].y) + (v[j].z * v[j].z + v[j].w * v[j].w); }
    const float r = rsqrtf(wave_sum(s) * (1.f / DM) + EPSN);
#pragma unroll
    for (int j = 0; j < 4; ++j) { const f32x4 gv = ((const f32x4*)g)[lane + 64 * j]; u32x2 o; o.x = pk2(v[j].x * r * gv.x, v[j].y * r * gv.y); o.y = pk2(v[j].z * r * gv.z, v[j].w * r * gv.w);
        ((u32x2*)orow)[lane + 64 * j] = o; }
}
__device__ __forceinline__ void rms_row_f32(float* xrow, const float* g, int lane) {
    f32x4 v[4]; float s = 0.f;
#pragma unroll
    for (int j = 0; j < 4; ++j) { v[j] = ((const f32x4*)xrow)[lane + 64 * j]; s += (v[j].x * v[j].x + v[j].y * v[j].y) + (v[j].z * v[j].z + v[j].w * v[j].w); }
    const float r = rsqrtf(wave_sum(s) * (1.f / DM) + EPSN);
#pragma unroll
    for (int j = 0; j < 4; ++j) { const f32x4 gv = ((const f32x4*)g)[lane + 64 * j]; ((f32x4*)xrow)[lane + 64 * j] = v[j] * r * gv; }
}
__device__ __forceinline__ void phase_norm_bf16(const Params& p, const float* x, const float* g, bf16_t* H, int wid, int lane) {
    for (int m = p.bid * 8 + wid; m < NT; m += p.gdim * 8) rms_row_bf16(x + (size_t)m * DM, g, H + (size_t)m * DM, lane);
}

__device__ __forceinline__ void phase_prologue(const Params& p, LAS unsigned char* lds, int tid, int wid, int lane) {
    unsigned char* ws = p.ws;
    LAS float* scr = (LAS float*)(lds + wid * 16384);
    const int gw = p.bid * 8 + wid, NGW = p.gdim * 8;
    constexpr int I_IN = 16 * 97, I_OUT = 16 * 32, I_F1 = 16 * 128, I_F2 = 64 * 32, I_C1 = 32 * 8, I_C2 = 4 * 2;
    constexpr int PER = I_IN + I_OUT + I_F1 + I_F2 + 2 * I_C1 + 2 * I_C2;
    for (int it = gw; it < 2 * PER; it += NGW) {
        const int l = it / PER; int r = it % PER;
        if (r < I_IN) { transpose_item<true>(p.w_in + (size_t)l * DM * INC, DM, INC, (bf16_t*)(ws + WS_WIN) + (size_t)l * ZLD * DM, scr, r, lane); continue; } r -= I_IN;
        if (r < I_OUT) { transpose_item<false>(p.w_out + (size_t)l * DM * DM, DM, DM, (bf16_t*)(ws + WS_WOUT) + (size_t)l * DM * DM, scr, r, lane); continue; } r -= I_OUT;
        if (r < I_F1) { transpose_item<false>(p.w_ff1 + (size_t)l * DM * DFF, DM, DFF, (bf16_t*)(ws + WS_WF1) + (size_t)l * DM * DFF, scr, r, lane); continue; } r -= I_F1;
        if (r < I_F2) { transpose_item<false>(p.w_ff2 + (size_t)l * DM * DFF, DFF, DM, (bf16_t*)(ws + WS_WF2) + (size_t)l * DM * DFF, scr, r, lane); continue; } r -= I_F2;
        if (r < 2 * I_C1) { const int kv = r / I_C1; transpose_item<false>(p.nsa_w1 + (size_t)(l * 2 + kv) * 2048 * 256, 2048, 256, (bf16_t*)(ws + WS_WC1) + (size_t)(l * 2 + kv) * 256 * 2048, scr, r % I_C1, lane); continue; } r -= 2 * I_C1;
        { const int kv = r / I_C2; transpose_item<false>(p.nsa_w2 + (size_t)(l * 2 + kv) * 256 * 64, 256, 64, (bf16_t*)(ws + WS_WC2) + (size_t)(l * 2 + kv) * 64 * 256, scr, r % I_C2, lane); }
    }
    __syncthreads();
    for (int it = p.bid; it < 16; it += p.gdim) {
        const int lk = it >> 2, n = (it & 3) * 64 + lane; const float* pe = p.nsa_pe + (size_t)lk * 2048 + wid * 256; const float* w1 = p.nsa_w1 + ((size_t)lk * 2048 + wid * 256) * 256 + n;
        float s0 = 0.f, s1 = 0.f, s2 = 0.f, s3 = 0.f;
#pragma unroll 4
        for (int kk = 0; kk < 256; kk += 4) { s0 += pe[kk] * w1[(size_t)kk * 256]; s1 += pe[kk + 1] * w1[(size_t)(kk + 1) * 256]; s2 += pe[kk + 2] * w1[(size_t)(kk + 2) * 256]; s3 += pe[kk + 3] * w1[(size_t)(kk + 3) * 256]; }
        LAS float* red = (LAS float*)lds;
        __syncthreads();
        red[wid * 64 + lane] = (s0 + s1) + (s2 + s3);
        __syncthreads();
        if (wid == 0) { float t = 0.f;
#pragma unroll
            for (int w = 0; w < 8; ++w) t += red[w * 64 + lane];
            ((float*)(ws + WS_CB))[lk * 256 + n] = t; }
    }
    __syncthreads();
    if (p.bid == 0 && tid < 2) ((unsigned*)(ws + WS_QCTR))[64 * tid] = 0u;
    phase_norm_bf16(p, p.x, p.norm1, (bf16_t*)(ws + WS_HM), wid, lane);
}

__device__ __forceinline__ bf16x8 scale_frag(bf16x8 q, float c) { float v[8]; unpack8(__builtin_bit_cast(u32x4, q), v); return pack8(v[0] * c, v[1] * c, v[2] * c, v[3] * c, v[4] * c, v[5] * c, v[6] * c, v[7] * c); }
constexpr int KP = 72, VP = 72;
#define TL_DECL const int kkey_ = tid >> 3, kch_ = tid & 7, vkey_ = tid & 63, vch_ = tid >> 6; u32x4 kr_ = {0u, 0u, 0u, 0u}, vr_ = {0u, 0u, 0u, 0u};
#define TL_FETCH(Kg, kpitch, Vg, vpitch, t) do { kr_ = *(const u32x4*)((Kg) + (size_t)(64 * (t) + kkey_) * (kpitch) + kch_ * 8); \
        vr_ = *(const u32x4*)((Vg) + (size_t)(64 * (t) + vkey_) * (vpitch) + vch_ * 8); } while (0)
constexpr int TLB = 64 * KP + 64 * VP;
#define TL_WRITE(bi) do { LAS bf16_t* ks_ = Ks0 + (bi) * TLB; LAS bf16_t* vt_ = ks_ + 64 * KP; *(LAS u32x4*)(ks_ + kkey_ * KP + kch_ * 8) = kr_; \
        vt_[(vch_ * 8 + 0) * VP + vkey_] = (bf16_t)(vr_.x & 0xffffu); vt_[(vch_ * 8 + 1) * VP + vkey_] = (bf16_t)(vr_.x >> 16); \
        vt_[(vch_ * 8 + 2) * VP + vkey_] = (bf16_t)(vr_.y & 0xffffu); vt_[(vch_ * 8 + 3) * VP + vkey_] = (bf16_t)(vr_.y >> 16); \
        vt_[(vch_ * 8 + 4) * VP + vkey_] = (bf16_t)(vr_.z & 0xffffu); vt_[(vch_ * 8 + 5) * VP + vkey_] = (bf16_t)(vr_.z >> 16); \
        vt_[(vch_ * 8 + 6) * VP + vkey_] = (bf16_t)(vr_.w & 0xffffu); vt_[(vch_ * 8 + 7) * VP + vkey_] = (bf16_t)(vr_.w >> 16); } while (0)
#define TL_BEGIN(Kg, kpitch, Vg, vpitch, t0, t1) do { TL_FETCH(Kg, kpitch, Vg, vpitch, t0); TL_WRITE(0); __syncthreads(); if ((t0) + 1 < (t1)) TL_FETCH(Kg, kpitch, Vg, vpitch, (t0) + 1); } while (0)
#define TL_NEXT(Kg, kpitch, Vg, vpitch, t, t1, bi) do { if ((t) + 1 < (t1)) { TL_WRITE((bi) ^ 1); if ((t) + 2 < (t1)) TL_FETCH(Kg, kpitch, Vg, vpitch, (t) + 2); } __syncthreads(); } while (0)

template <int ND>
__device__ __forceinline__ f32x16 qk_sub(const bf16x8 (&qf)[ND], const LAS bf16_t* Ks, int kr0, int kc0, int r, int h) {
    f32x16 s;
#pragma unroll
    for (int i = 0; i < 16; ++i) s[i] = 0.f;
#pragma unroll
    for (int ks = 0; ks < ND; ++ks) { const bf16x8 a = *(const LAS bf16x8*)(Ks + (kr0 + r) * KP + kc0 + 16 * ks + 8 * h); s = __builtin_amdgcn_mfma_f32_32x32x16_bf16(a, qf[ks], s, 0, 0, 0); }
    return s;
}
template <int MODE> __device__ __forceinline__ bool key_ok(int key, int qpos) {
    if (MODE == 0) return key <= qpos;
    if (MODE == 1) return (key <= qpos) && (key > qpos - 512);
    return 16 * key + 31 <= qpos;
}
template <int ND, int MODE>
__device__ __forceinline__ void attn_sub(float& m, float& l, f32x16& o0, f32x16& o1, const bf16x8 (&qf)[ND], const LAS bf16_t* Ks, const LAS bf16_t* Vt,
                                         int kr0, int kc0, int key0, int qpos, float c, bool need_mask, int r, int h) {
    f32x16 s = qk_sub<ND>(qf, Ks, kr0, kc0, r, h);
    if (need_mask) {
#pragma unroll
        for (int i = 0; i < 16; ++i) { const int key = key0 + rowi32(i, h); s[i] = key_ok<MODE>(key, qpos) ? s[i] : NEG; }
    }
    float mt = s[0];
#pragma unroll
    for (int i = 1; i < 16; ++i) mt = fmaxf(mt, s[i]);
    mt = fmaxf(mt, __shfl_xor(mt, 32));
    const float mn = fmaxf(m, mt);
    float alpha = 1.f;
    if (__any(mn != m)) {
        alpha = ex2((m - mn) * c);
#pragma unroll
        for (int i = 0; i < 16; ++i) { o0[i] *= alpha; o1[i] *= alpha; }
    }
    m = mn;
    float pv[16]; f32x2_t ps2 = {0.f, 0.f}; const f32x2_t c2 = {c, c}, mn2 = {mn, mn};
#pragma unroll
    for (int i = 0; i < 8; ++i) { f32x2_t tt = {s[2 * i], s[2 * i + 1]}; tt = (tt - mn2) * c2; pv[2 * i] = ex2(tt.x); pv[2 * i + 1] = ex2(tt.y); const f32x2_t pp = {pv[2 * i], pv[2 * i + 1]}; ps2 += pp; }
    l = l * alpha + (ps2.x + ps2.y);
#pragma unroll
    for (int s2 = 0; s2 < 2; ++s2) {
        const bf16x8 pb = pack8(pv[8 * s2 + 0], pv[8 * s2 + 1], pv[8 * s2 + 2], pv[8 * s2 + 3], pv[8 * s2 + 4], pv[8 * s2 + 5], pv[8 * s2 + 6], pv[8 * s2 + 7]);
        const LAS bf16_t* vp = Vt + r * VP + kr0 + 16 * s2 + 4 * h;
        const u32x2 a0l = *(const LAS u32x2*)vp, a0h = *(const LAS u32x2*)(vp + 8);
        const u32x2 a1l = *(const LAS u32x2*)(vp + 32 * VP), a1h = *(const LAS u32x2*)(vp + 32 * VP + 8);
        u32x4 a0 = {a0l.x, a0l.y, a0h.x, a0h.y}, a1 = {a1l.x, a1l.y, a1h.x, a1h.y};
        o0 = __builtin_amdgcn_mfma_f32_32x32x16_bf16(__builtin_bit_cast(bf16x8, a0), pb, o0, 0, 0, 0);
        o1 = __builtin_amdgcn_mfma_f32_32x32x16_bf16(__builtin_bit_cast(bf16x8, a1), pb, o1, 0, 0, 0);
    }
}

__device__ __forceinline__ void attn_sub_x2(float& m1, float& l1, f32x16& oa0, f32x16& oa1, float& m2, float& l2, f32x16& ob0, f32x16& ob1,
                                            const bf16x8 (&qf1)[2], const bf16x8 (&qf2)[2], const LAS bf16_t* Ks, const LAS bf16_t* Vt, int kr0, int key0, int qpos, float c, bool need_mask, int r, int h) {
    f32x16 s1 = qk_sub<2>(qf1, Ks, kr0, 0, r, h), s2 = qk_sub<2>(qf2, Ks, kr0, 32, r, h);
    if (need_mask) {
#pragma unroll
        for (int i = 0; i < 16; ++i) { const bool ok = (key0 + rowi32(i, h)) <= qpos; s1[i] = ok ? s1[i] : NEG; s2[i] = ok ? s2[i] : NEG; }
    }
    float mt1 = s1[0], mt2 = s2[0];
#pragma unroll
    for (int i = 1; i < 16; ++i) { mt1 = fmaxf(mt1, s1[i]); mt2 = fmaxf(mt2, s2[i]); }
    mt1 = fmaxf(mt1, __shfl_xor(mt1, 32)); mt2 = fmaxf(mt2, __shfl_xor(mt2, 32));
    const float mn1 = fmaxf(m1, mt1), mn2 = fmaxf(m2, mt2);
    float al1 = 1.f, al2 = 1.f;
    if (__any((mn1 != m1) | (mn2 != m2))) {
        al1 = ex2((m1 - mn1) * c); al2 = ex2((m2 - mn2) * c);
#pragma unroll
        for (int i = 0; i < 16; ++i) { oa0[i] *= al1; oa1[i] *= al1; ob0[i] *= al2; ob1[i] *= al2; }
    }
    m1 = mn1; m2 = mn2;
    float p1[16], p2[16]; f32x2_t a1 = {0.f, 0.f}, a2 = {0.f, 0.f}; const f32x2_t c2 = {c, c}, mA = {mn1, mn1}, mB = {mn2, mn2};
#pragma unroll
    for (int i = 0; i < 8; ++i) { f32x2_t t1 = {s1[2 * i], s1[2 * i + 1]}, t2 = {s2[2 * i], s2[2 * i + 1]}; t1 = (t1 - mA) * c2; t2 = (t2 - mB) * c2;
        p1[2 * i] = ex2(t1.x); p1[2 * i + 1] = ex2(t1.y); p2[2 * i] = ex2(t2.x); p2[2 * i + 1] = ex2(t2.y);
        const f32x2_t u1 = {p1[2 * i], p1[2 * i + 1]}, u2 = {p2[2 * i], p2[2 * i + 1]}; a1 += u1; a2 += u2; }
    l1 = l1 * al1 + (a1.x + a1.y); l2 = l2 * al2 + (a2.x + a2.y);
#pragma unroll
    for (int s2i = 0; s2i < 2; ++s2i) {
        const bf16x8 pb1 = pack8(p1[8 * s2i + 0], p1[8 * s2i + 1], p1[8 * s2i + 2], p1[8 * s2i + 3], p1[8 * s2i + 4], p1[8 * s2i + 5], p1[8 * s2i + 6], p1[8 * s2i + 7]);
        const bf16x8 pb2 = pack8(p2[8 * s2i + 0], p2[8 * s2i + 1], p2[8 * s2i + 2], p2[8 * s2i + 3], p2[8 * s2i + 4], p2[8 * s2i + 5], p2[8 * s2i + 6], p2[8 * s2i + 7]);
        const LAS bf16_t* vp = Vt + r * VP + kr0 + 16 * s2i + 4 * h;
        const u32x2 a0l = *(const LAS u32x2*)vp, a0h = *(const LAS u32x2*)(vp + 8);
        const u32x2 a1l = *(const LAS u32x2*)(vp + 32 * VP), a1h = *(const LAS u32x2*)(vp + 32 * VP + 8);
        const u32x4 v0 = {a0l.x, a0l.y, a0h.x, a0h.y}, v1 = {a1l.x, a1l.y, a1h.x, a1h.y};
        oa0 = __builtin_amdgcn_mfma_f32_32x32x16_bf16(__builtin_bit_cast(bf16x8, v0), pb1, oa0, 0, 0, 0);
        ob0 = __builtin_amdgcn_mfma_f32_32x32x16_bf16(__builtin_bit_cast(bf16x8, v0), pb2, ob0, 0, 0, 0);
        oa1 = __builtin_amdgcn_mfma_f32_32x32x16_bf16(__builtin_bit_cast(bf16x8, v1), pb1, oa1, 0, 0, 0);
        ob1 = __builtin_amdgcn_mfma_f32_32x32x16_bf16(__builtin_bit_cast(bf16x8, v1), pb2, ob1, 0, 0, 0);
    }
}

__device__ __forceinline__ void attn_fast_x2(float mr1, f32x16& L1, f32x16& oa0, f32x16& oa1, float mr2, f32x16& L2, f32x16& ob0, f32x16& ob1,
                                             const bf16x8 (&qf1)[2], const bf16x8 (&qf2)[2], const LAS bf16_t* Ks, const LAS bf16_t* Vt, int kr0, int key0, int qpos, bool need_mask, int r, int h) {
    f32x16 s1, s2;
#pragma unroll
    for (int i = 0; i < 16; ++i) { s1[i] = -mr1; s2[i] = -mr2; }
#pragma unroll
    for (int ks = 0; ks < 2; ++ks) { const bf16x8 a1 = *(const LAS bf16x8*)(Ks + (kr0 + r) * KP + 16 * ks + 8 * h), a2 = *(const LAS bf16x8*)(Ks + (kr0 + r) * KP + 32 + 16 * ks + 8 * h);
        s1 = __builtin_amdgcn_mfma_f32_32x32x16_bf16(a1, qf1[ks], s1, 0, 0, 0); s2 = __builtin_amdgcn_mfma_f32_32x32x16_bf16(a2, qf2[ks], s2, 0, 0, 0); }
    if (need_mask) {
#pragma unroll
        for (int i = 0; i < 16; ++i) { const bool ok = (key0 + rowi32(i, h)) <= qpos; s1[i] = ok ? s1[i] : NEG; s2[i] = ok ? s2[i] : NEG; }
    }
    float p1[16], p2[16];
#pragma unroll
    for (int i = 0; i < 16; ++i) { p1[i] = ex2(s1[i]); p2[i] = ex2(s2[i]); }
    const u32x4 onesu = {0x3f803f80u, 0x3f803f80u, 0x3f803f80u, 0x3f803f80u}; const bf16x8 ones = __builtin_bit_cast(bf16x8, onesu);
#pragma unroll
    for (int s2i = 0; s2i < 2; ++s2i) {
        const bf16x8 pb1 = pack8(p1[8 * s2i + 0], p1[8 * s2i + 1], p1[8 * s2i + 2], p1[8 * s2i + 3], p1[8 * s2i + 4], p1[8 * s2i + 5], p1[8 * s2i + 6], p1[8 * s2i + 7]);
        const bf16x8 pb2 = pack8(p2[8 * s2i + 0], p2[8 * s2i + 1], p2[8 * s2i + 2], p2[8 * s2i + 3], p2[8 * s2i + 4], p2[8 * s2i + 5], p2[8 * s2i + 6], p2[8 * s2i + 7]);
        const LAS bf16_t* vp = Vt + r * VP + kr0 + 16 * s2i + 4 * h;
        const u32x2 a0l = *(const LAS u32x2*)vp, a0h = *(const LAS u32x2*)(vp + 8);
        const u32x2 a1l = *(const LAS u32x2*)(vp + 32 * VP), a1h = *(const LAS u32x2*)(vp + 32 * VP + 8);
        const u32x4 v0 = {a0l.x, a0l.y, a0h.x, a0h.y}, v1 = {a1l.x, a1l.y, a1h.x, a1h.y};
        oa0 = __builtin_amdgcn_mfma_f32_32x32x16_bf16(__builtin_bit_cast(bf16x8, v0), pb1, oa0, 0, 0, 0);
        ob0 = __builtin_amdgcn_mfma_f32_32x32x16_bf16(__builtin_bit_cast(bf16x8, v0), pb2, ob0, 0, 0, 0);
        oa1 = __builtin_amdgcn_mfma_f32_32x32x16_bf16(__builtin_bit_cast(bf16x8, v1), pb1, oa1, 0, 0, 0);
        ob1 = __builtin_amdgcn_mfma_f32_32x32x16_bf16(__builtin_bit_cast(bf16x8, v1), pb2, ob1, 0, 0, 0);
        L1 = __builtin_amdgcn_mfma_f32_32x32x16_bf16(ones, pb1, L1, 0, 0, 0);
        L2 = __builtin_amdgcn_mfma_f32_32x32x16_bf16(ones, pb2, L2, 0, 0, 0);
    }
}

__device__ __forceinline__ void phase_da(const Params& p, int layer, LAS unsigned char* lds, const bf16_t* Z, bf16_t* Mixed, int tid, int wid, int lane) {
    LAS bf16_t* Ks0 = (LAS bf16_t*)lds;
    const int r = lane & 31, h = lane >> 5;
    const float lam_init = 0.8f - 0.6f * expf(-0.3f * (float)layer);
    float lam;
    { const float* lf = p.da_lambda + layer * 128; float s1 = 0.f, s2 = 0.f;
      for (int i = 0; i < 32; ++i) { s1 += lf[i] * lf[32 + i]; s2 += lf[64 + i] * lf[96 + i]; }
      lam = expf(s1) - expf(s2) + lam_init; }
    const float c = 0.17677669529663687f * LOG2E;
    const float* gain = p.da_norm + layer * 256;
    TL_DECL
    for (int pr = p.bid; pr < 256; pr += p.gdim) {
        const int b = pr >> 7, hd = (pr >> 5) & 3, qa = pr & 31;
        const bf16_t* Kg = Z + (size_t)b * SEQ * ZLD + C_DAK + hd * 64;
        const bf16_t* Vg = Z + (size_t)b * SEQ * ZLD + C_DAV + hd * 64;
        for (int half = 0; half < 2; ++half) {
            const int qb = half ? 63 - qa : qa;
            const int q0w = qb * 256 + 32 * wid, qpos = q0w + r;
            const size_t row = (size_t)b * SEQ + qpos;
            bf16x8 qf1[2], qf2[2];
#pragma unroll
            for (int ks = 0; ks < 2; ++ks) { qf1[ks] = scale_frag(*(const bf16x8*)(Z + row * ZLD + C_DAQ + hd * 64 + 16 * ks + 8 * h), c); qf2[ks] = scale_frag(*(const bf16x8*)(Z + row * ZLD + C_DAQ + hd * 64 + 32 + 16 * ks + 8 * h), c); }
            float m1 = NEG, l1 = 0.f, m2 = NEG, l2 = 0.f; f32x16 oa0, oa1, ob0, ob1;
#pragma unroll
            for (int i = 0; i < 16; ++i) { oa0[i] = 0.f; oa1[i] = 0.f; ob0[i] = 0.f; ob1[i] = 0.f; }
            const int ntile = 4 * (qb + 1);
            f32x16 L1, L2;
            TL_BEGIN(Kg, ZLD, Vg, ZLD, 0, ntile);
            for (int t = 0, bi = 0; t < ntile; ++t, bi ^= 1) {
                const LAS bf16_t* Ks = Ks0 + bi * TLB; const LAS bf16_t* Vt = Ks + 64 * KP;
#pragma unroll
                for (int sub = 0; sub < 2; ++sub) {
                    const int k0 = 64 * t + 32 * sub;
                    if (k0 > q0w + 31) continue;
                    const bool nm = (k0 + 31 > q0w);
                    if (t == 0 && sub == 0) {
                        attn_sub_x2(m1, l1, oa0, oa1, m2, l2, ob0, ob1, qf1, qf2, Ks, Vt, 0, k0, qpos, 1.0f, nm, r, h);
                        l1 += __shfl_xor(l1, 32); l2 += __shfl_xor(l2, 32);
#pragma unroll
                        for (int i = 0; i < 16; ++i) { L1[i] = l1; L2[i] = l2; }
                    } else attn_fast_x2(m1, L1, oa0, oa1, m2, L2, ob0, ob1, qf1, qf2, Ks, Vt, 32 * sub, k0, qpos, nm, r, h);
                }
                if (__any((L1[0] > 1e30f) | (L2[0] > 1e30f))) {
                    m1 += 100.f; m2 += 100.f; const float dn = 7.888609052210118e-31f;
#pragma unroll
                    for (int i = 0; i < 16; ++i) { oa0[i] *= dn; oa1[i] *= dn; ob0[i] *= dn; ob1[i] *= dn; L1[i] *= dn; L2[i] *= dn; }
                }
                TL_NEXT(Kg, ZLD, Vg, ZLD, t, ntile, bi);
            }
            l1 = L1[0]; l2 = L2[0];
            const float i1 = 1.f / l1, i2 = lam / l2;
            float ss = 0.f;
#pragma unroll
            for (int i = 0; i < 16; ++i) { oa0[i] = oa0[i] * i1 - ob0[i] * i2; oa1[i] = oa1[i] * i1 - ob1[i] * i2; ss += oa0[i] * oa0[i] + oa1[i] * oa1[i]; }
            ss += __shfl_xor(ss, 32);
            const float rn = rsqrtf(ss * (1.f / 64.f) + EPSN) * (1.f - lam_init);
            bf16_t* orow = Mixed + row * DM + 256 + hd * 64;
#pragma unroll
            for (int g4 = 0; g4 < 4; ++g4) {
                const int dv = 8 * g4 + 4 * h; const f32x4 ga = *(const f32x4*)(gain + hd * 64 + dv), gb = *(const f32x4*)(gain + hd * 64 + 32 + dv);
                u32x2 wa, wb;
                wa.x = pk2(oa0[4 * g4 + 0] * rn * ga.x, oa0[4 * g4 + 1] * rn * ga.y); wa.y = pk2(oa0[4 * g4 + 2] * rn * ga.z, oa0[4 * g4 + 3] * rn * ga.w);
                wb.x = pk2(oa1[4 * g4 + 0] * rn * gb.x, oa1[4 * g4 + 1] * rn * gb.y); wb.y = pk2(oa1[4 * g4 + 2] * rn * gb.z, oa1[4 * g4 + 3] * rn * gb.w);
                *(u32x2*)(orow + dv) = wa; *(u32x2*)(orow + 32 + dv) = wb;
            }
        }
    }
}

__device__ __forceinline__ void phase_win(const Params& p, LAS unsigned char* lds, const bf16_t* Z, const float* G, bf16_t* ACCW, int tid, int wid, int lane) {
    LAS bf16_t* Ks0 = (LAS bf16_t*)lds;
    const int r = lane & 31, h = lane >> 5, hh = wid & 3, qs = wid >> 2;
    const float c = 0.125f * LOG2E;
    TL_DECL
    for (int item = p.bid; item < 1024; item += p.gdim) {
        const int bg = item >> 8, qb = item & 255, b = bg >> 1, g = bg & 1, head = g * 4 + hh;
        const bf16_t* Kg = Z + (size_t)b * SEQ * ZLD + C_KW + g * 64;
        const bf16_t* Vg = Z + (size_t)b * SEQ * ZLD + C_VW + g * 64;
        const int q0w = qb * 64 + 32 * qs, qpos = q0w + r; const size_t row = (size_t)b * SEQ + qpos;
        bf16x8 qf[4];
#pragma unroll
        for (int ks = 0; ks < 4; ++ks) qf[ks] = scale_frag(*(const bf16x8*)(Z + row * ZLD + C_NSQ + head * 64 + 16 * ks + 8 * h), c);
        float m = NEG, l = 0.f; f32x16 o0, o1;
#pragma unroll
        for (int i = 0; i < 16; ++i) { o0[i] = 0.f; o1[i] = 0.f; }
        const int tlo = qb >= 8 ? qb - 8 : 0;
        TL_BEGIN(Kg, ZLD, Vg, ZLD, tlo, qb + 1);
        for (int t = tlo, bi = 0; t <= qb; ++t, bi ^= 1) {
            const LAS bf16_t* Ks = Ks0 + bi * TLB; const LAS bf16_t* Vt = Ks + 64 * KP;
#pragma unroll
            for (int sub = 0; sub < 2; ++sub) {
                const int k0 = 64 * t + 32 * sub;
                if (k0 > q0w + 31 || k0 + 31 <= q0w - 512) continue;
                const bool nm = !((k0 + 31 <= q0w) && (k0 > q0w + 31 - 512));
                attn_sub<4, 1>(m, l, o0, o1, qf, Ks, Vt, 32 * sub, 0, k0, qpos, 1.0f, nm, r, h);
            }
            TL_NEXT(Kg, ZLD, Vg, ZLD, t, qb + 1, bi);
        }
        l += __shfl_xor(l, 32);
        const float gate = sigmoidf_(G[row * 32 + 8 + head * 3 + 2]);
        const float sc = (m > -1e29f) ? gate / l : 0.f;
        bf16_t* arow = ACCW + row * 512 + head * 64;
#pragma unroll
        for (int g4 = 0; g4 < 4; ++g4) { const int dv = 8 * g4 + 4 * h;
            u32x2 a, bq; a.x = pk2(o0[4 * g4] * sc, o0[4 * g4 + 1] * sc); a.y = pk2(o0[4 * g4 + 2] * sc, o0[4 * g4 + 3] * sc);
            bq.x = pk2(o1[4 * g4] * sc, o1[4 * g4 + 1] * sc); bq.y = pk2(o1[4 * g4 + 2] * sc, o1[4 * g4 + 3] * sc);
            *(u32x2*)(arow + dv) = a; *(u32x2*)(arow + 32 + dv) = bq; }
    }
}

__device__ __forceinline__ float gelu_tanh(float x) { const float u = 0.7978845608028654f * (x + 0.044715f * x * x * x); const float e = __expf(2.f * u); const float th = 1.f - 2.f / (e + 1.f); return 0.5f * x * (1.f + th); }
__device__ __forceinline__ void phase_compress(const Params& p, int layer, LAS unsigned char* lds, const bf16_t* Z, bf16_t* KC, int tid, int wid, int lane) {
    LAS bf16_t* As = (LAS bf16_t*)lds;
    LAS bf16_t* Hs = As + 32 * 72;
    const int r = lane & 31, h = lane >> 5;
    const float* CB = (const float*)(p.ws + WS_CB);
    for (int item = p.bid; item < 256; item += p.gdim) {
        const int kv = item >> 7, bg = (item >> 5) & 3, rt = item & 31, c0 = rt * 32, b = bg >> 1, g = bg & 1;
        const bf16_t* src = Z + (size_t)b * SEQ * ZLD + (kv ? C_VC : C_KC) + g * 64;
        const bf16_t* W1 = (const bf16_t*)(p.ws + WS_WC1) + (size_t)(layer * 2 + kv) * 256 * 2048;
        const bf16_t* W2 = (const bf16_t*)(p.ws + WS_WC2) + (size_t)(layer * 2 + kv) * 64 * 256;
        const int n = wid * 32 + r;
        f32x16 acc;
#pragma unroll
        for (int i = 0; i < 16; ++i) acc[i] = 0.f;
        bf16x8 bf[4]; u32x4 av = {0u, 0u, 0u, 0u};
#define CMPRS_LOAD(tok_) do { _Pragma("unroll") for (int ks_ = 0; ks_ < 4; ++ks_) bf[ks_] = *(const bf16x8*)(W1 + (size_t)n * 2048 + (tok_) * 64 + 16 * ks_ + 8 * h); \
            if (tid < 256) { int token_ = 16 * (c0 + (tid >> 3)) + (tok_); token_ = token_ < SEQ ? token_ : SEQ - 1; av = *(const u32x4*)(src + (size_t)token_ * ZLD + (tid & 7) * 8); } } while (0)
        CMPRS_LOAD(0);
        for (int tok = 0; tok < 32; ++tok) {
            __syncthreads();
            if (tid < 256) *(LAS u32x4*)(As + (tid >> 3) * 72 + (tid & 7) * 8) = av;
            bf16x8 bc[4];
#pragma unroll
            for (int ks = 0; ks < 4; ++ks) bc[ks] = bf[ks];
            __syncthreads();
            if (tok + 1 < 32) CMPRS_LOAD(tok + 1);
#pragma unroll
            for (int ks = 0; ks < 4; ++ks) { const bf16x8 a = *(const LAS bf16x8*)(As + r * 72 + 16 * ks + 8 * h); acc = __builtin_amdgcn_mfma_f32_32x32x16_bf16(a, bc[ks], acc, 0, 0, 0); }
        }
#undef CMPRS_LOAD
        const float bias = CB[(layer * 2 + kv) * 256 + n];
#pragma unroll
        for (int i = 0; i < 16; ++i) Hs[rowi32(i, h) * 264 + n] = f2bf(gelu_tanh(acc[i] + bias));
        __syncthreads();
        if (wid < 2) {
            f32x16 o;
#pragma unroll
            for (int i = 0; i < 16; ++i) o[i] = 0.f;
            const int n2 = wid * 32 + r;
#pragma unroll
            for (int ks = 0; ks < 16; ++ks) { const bf16x8 a = *(const LAS bf16x8*)(Hs + r * 264 + 16 * ks + 8 * h); const bf16x8 bw = *(const bf16x8*)(W2 + (size_t)n2 * 256 + 16 * ks + 8 * h);
                o = __builtin_amdgcn_mfma_f32_32x32x16_bf16(a, bw, o, 0, 0, 0); }
#pragma unroll
            for (int i = 0; i < 16; ++i) { float v = o[i];
#if DBG_SCRUBKC
                if (!(fabsf(v) < 1e4f)) v = 0.f;
#endif
                KC[((size_t)(kv * 4 + bg) * 1024 + c0 + rowi32(i, h)) * 64 + n2] = f2bf(v); }
        }
        __syncthreads();
    }
}

typedef unsigned long long u64_t;
__device__ __forceinline__ unsigned pk4_fp8(float a, float b, float c, float d) { int w = __builtin_amdgcn_cvt_pk_fp8_f32(a, b, 0, false); w = __builtin_amdgcn_cvt_pk_fp8_f32(c, d, w, true); return (unsigned)w; }
__device__ __forceinline__ u32x2 bf8_to_fp8(u32x4 v) {
    u32x2 o;
    o.x = pk4_fp8(__uint_as_float(v.x << 16), __uint_as_float(v.x & 0xffff0000u), __uint_as_float(v.y << 16), __uint_as_float(v.y & 0xffff0000u));
    o.y = pk4_fp8(__uint_as_float(v.z << 16), __uint_as_float(v.z & 0xffff0000u), __uint_as_float(v.w << 16), __uint_as_float(v.w & 0xffff0000u));
    return o;
}
__device__ __forceinline__ void phase_vst(const Params& p, LAS unsigned char* lds, const bf16_t* Z, unsigned char* K8, unsigned char* V8T, int tid) {
    LAS bf16_t* Vt = (LAS bf16_t*)lds;
    const int vkey = tid & 63, vch = tid >> 6;
    for (int item = p.bid; item < 1024; item += p.gdim) {
        const int bg = item >> 8, tt = item & 255, b = bg >> 1, g = bg & 1;
        const u32x4 v = *(const u32x4*)(Z + ((size_t)b * SEQ + 64 * tt + vkey) * ZLD + C_VS + g * 64 + vch * 8);
        { const int key = tid >> 3, ch = tid & 7;
          const u32x4 kk = *(const u32x4*)(Z + ((size_t)b * SEQ + 64 * tt + key) * ZLD + C_KS + g * 64 + ch * 8);
          *(u32x2*)(K8 + ((size_t)bg * SEQ + 64 * tt + key) * 64 + (ch & 3) * 16 + (ch >> 2) * 8) = bf8_to_fp8(kk); }
        __syncthreads();
        Vt[(vch * 8 + 0) * VP + vkey] = (bf16_t)(v.x & 0xffffu); Vt[(vch * 8 + 1) * VP + vkey] = (bf16_t)(v.x >> 16);
        Vt[(vch * 8 + 2) * VP + vkey] = (bf16_t)(v.y & 0xffffu); Vt[(vch * 8 + 3) * VP + vkey] = (bf16_t)(v.y >> 16);
        Vt[(vch * 8 + 4) * VP + vkey] = (bf16_t)(v.z & 0xffffu); Vt[(vch * 8 + 5) * VP + vkey] = (bf16_t)(v.z >> 16);
        Vt[(vch * 8 + 6) * VP + vkey] = (bf16_t)(v.w & 0xffffu); Vt[(vch * 8 + 7) * VP + vkey] = (bf16_t)(v.w >> 16);
        __syncthreads();
        const int dv = tid >> 3, ch = tid & 7;
        *(u32x2*)(V8T + (((size_t)bg * 256 + tt) * 64 + dv) * 64 + (ch & 3) * 16 + (ch >> 2) * 8) = bf8_to_fp8(*(const LAS u32x4*)(Vt + dv * VP + ch * 8));
    }
}

__device__ __forceinline__ void ml_scan_line(float* __restrict__ pc, size_t stride, const float* __restrict__ GA, float* __restrict__ MP, int bh, bool write_m);
__device__ __forceinline__ void phase_cmp(const Params& p, LAS unsigned char* lds, const bf16_t* Z, const float* G, const bf16_t* KC, const bf16_t* ACCW, float* ACC, int* IDX,
                                          float* CL, float* NL, const float* GA, float* MP, unsigned* ctr, int tid, int wid, int lane) {
    LAS int* qsh = (LAS int*)(lds + 106496);
    LAS bf16_t* Ks0 = (LAS bf16_t*)lds;
    LAS unsigned* PS = (LAS unsigned*)(lds + 40960);
    const int r = lane & 31, h = lane >> 5, hh = wid & 3, qs = wid >> 2;
    const float c = 0.125f * LOG2E;
    TL_DECL
    for (;;) {
        __syncthreads();
        if (tid == 0) qsh[0] = (int)__hip_atomic_fetch_add(ctr, 1u, __ATOMIC_RELAXED, __HIP_MEMORY_SCOPE_AGENT);
        __syncthreads();
        const int qit = qsh[0];
        if (qit >= 65 + 1024) break;
        if (qit < 65) {
            if (qit < 64) { const int gid = qit * 512 + tid, bh = gid >> 12, e = gid & 4095; ml_scan_line(CL + (size_t)bh * 256 * 4096 + e, 4096, GA, MP, bh, e == 0); }
            else { const int bh = tid >> 6, k = tid & 63; ml_scan_line(NL + (size_t)bh * 256 * 64 + k, 64, GA, MP, bh, false); }
            continue;
        }
        const int bg = (qit - 65) & 3, qb = 255 - ((qit - 65) >> 2), b = bg >> 1, g = bg & 1, head = g * 4 + hh;
        const bf16_t* Kg = KC + (size_t)(0 * 4 + bg) * 1024 * 64;
        const bf16_t* Vg = KC + (size_t)(1 * 4 + bg) * 1024 * 64;
        const int q0w = qb * 64 + 32 * qs, qpos = q0w + r, ql = 32 * qs + r; const size_t row = (size_t)b * SEQ + qpos;
        bf16x8 qf[4];
#pragma unroll
        for (int ks = 0; ks < 4; ++ks) qf[ks] = scale_frag(*(const bf16x8*)(Z + row * ZLD + C_NSQ + head * 64 + 16 * ks + 8 * h), c);
        float m = NEG, l = 0.f; f32x16 o0, o1;
#pragma unroll
        for (int i = 0; i < 16; ++i) { o0[i] = 0.f; o1[i] = 0.f; }
        const int ncb = 4 * qb + 3, nt = (ncb + 63) >> 6;
        TL_BEGIN(Kg, 64, Vg, 64, 0, nt);
        for (int t = 0, bi = 0; t < nt; ++t, bi ^= 1) {
            const LAS bf16_t* Ks = Ks0 + bi * TLB; const LAS bf16_t* Vt = Ks + 64 * KP;
#pragma unroll
            for (int sub = 0; sub < 2; ++sub) {
                const int k0 = 64 * t + 32 * sub;
                if (16 * k0 + 31 > q0w + 31) continue;
                const bool nm = (16 * (k0 + 31) + 31 > q0w);
                attn_sub<4, 2>(m, l, o0, o1, qf, Ks, Vt, 32 * sub, 0, k0, qpos, 1.0f, nm, r, h);
            }
            TL_NEXT(Kg, 64, Vg, 64, t, nt, bi);
        }
        l += __shfl_xor(l, 32);
        const bool valid = m > -1e29f;
        const float invL = valid ? 1.f / l : 0.f;
        if (!DBG_NOCMPACC) {
            const float sc = sigmoidf_(G[row * 32 + 8 + head * 3 + 0]) * invL;
            float* arow = ACC + row * 512 + head * 64; const bf16_t* wrow = ACCW + row * 512 + head * 64;
#pragma unroll
            for (int g4 = 0; g4 < 4; ++g4) { const int dv = 8 * g4 + 4 * h;
                const u32x2 wa = *(const u32x2*)(wrow + dv), wb = *(const u32x2*)(wrow + 32 + dv);
                f32x4 a = {__uint_as_float(wa.x << 16), __uint_as_float(wa.x & 0xffff0000u), __uint_as_float(wa.y << 16), __uint_as_float(wa.y & 0xffff0000u)};
                f32x4 bq = {__uint_as_float(wb.x << 16), __uint_as_float(wb.x & 0xffff0000u), __uint_as_float(wb.y << 16), __uint_as_float(wb.y & 0xffff0000u)};
                a.x += o0[4 * g4] * sc; a.y += o0[4 * g4 + 1] * sc; a.z += o0[4 * g4 + 2] * sc; a.w += o0[4 * g4 + 3] * sc;
                bq.x += o1[4 * g4] * sc; bq.y += o1[4 * g4 + 1] * sc; bq.z += o1[4 * g4 + 2] * sc; bq.w += o1[4 * g4 + 3] * sc;
#if DBG_SCRUB
                for (int e = 0; e < 4; ++e) { if (!(fabsf(a[e]) < 1e20f)) a[e] = 0.f; if (!(fabsf(bq[e]) < 1e20f)) bq[e] = 0.f; }
#endif
                *(f32x4*)(arow + dv) = a; *(f32x4*)(arow + 32 + dv) = bq; }
        }
        if (qb >= 16) {
            __syncthreads();
            for (int e = tid; e < 16384; e += 512) PS[e] = 0u;
            TL_BEGIN(Kg, 64, Vg, 64, 0, nt);
            for (int t = 0, bi = 0; t < nt; ++t, bi ^= 1) {
                const LAS bf16_t* Ks = Ks0 + bi * TLB;
#pragma unroll
                for (int sub = 0; sub < 2; ++sub) {
                    const int k0 = 64 * t + 32 * sub;
                    if (16 * k0 + 31 > q0w + 31) continue;
                    f32x16 s = qk_sub<4>(qf, Ks, 32 * sub, 0, r, h);
#pragma unroll
                    for (int g4 = 0; g4 < 4; ++g4) {
                        float sum4 = 0.f, p3 = 0.f;
#pragma unroll
                        for (int e = 0; e < 4; ++e) { const int key = k0 + 8 * g4 + 4 * h + e; const float pv = (16 * key + 31 <= qpos) ? ex2(s[4 * g4 + e] - m) * invL : 0.f; sum4 += pv; if (e == 3) p3 = pv; }
                        const int j = (k0 >> 2) + 2 * g4 + h;
                        __hip_atomic_fetch_add((unsigned*)(PS + j * 64 + ql), (unsigned)(sum4 * 268435456.f + 0.5f), __ATOMIC_RELAXED, __HIP_MEMORY_SCOPE_WORKGROUP);
                        if (j + 1 < 256) __hip_atomic_fetch_add((unsigned*)(PS + (j + 1) * 64 + ql), (unsigned)(p3 * 268435456.f + 0.5f), __ATOMIC_RELAXED, __HIP_MEMORY_SCOPE_WORKGROUP);
                    }
                }
                TL_NEXT(Kg, 64, Vg, 64, t, nt, bi);
            }
            __syncthreads();
            for (int qi = wid; qi < 64; qi += 8) {
                const int cur = qb;
                unsigned v[4]; bool ok[4];
#pragma unroll
                for (int i = 0; i < 4; ++i) { const int j = lane + 64 * i; ok[i] = (j >= 1) && (j <= cur - 2); v[i] = ok[i] ? PS[j * 64 + qi] : 0u; }
                unsigned T = 0u;
                for (int bit = 30; bit >= 0; --bit) { const unsigned trial = T | (1u << bit); int cnt = 0;
#pragma unroll
                    for (int i = 0; i < 4; ++i) cnt += __builtin_popcountll(__ballot(ok[i] && v[i] >= trial));
                    if (cnt >= 13) T = trial; }
                int n_gt = 0;
#pragma unroll
                for (int i = 0; i < 4; ++i) n_gt += __builtin_popcountll(__ballot(ok[i] && v[i] > T));
                int* dst = IDX + (((size_t)b * SEQ + qb * 64 + qi) * 2 + g) * 16;
                if (lane == 0) { dst[0] = 0; dst[1] = cur - 1; dst[2] = cur; }
                int pos_gt = 3, eq_seen = 0; const int eq_base = 3 + n_gt, need = 13 - n_gt;
#pragma unroll
                for (int i = 0; i < 4; ++i) {
                    const bool gt = ok[i] && v[i] > T, eq = ok[i] && v[i] == T;
                    const unsigned long long mg = __ballot(gt), me = __ballot(eq);
                    const int rg = __builtin_amdgcn_mbcnt_hi((unsigned)(mg >> 32), __builtin_amdgcn_mbcnt_lo((unsigned)mg, 0u));
                    const int re = __builtin_amdgcn_mbcnt_hi((unsigned)(me >> 32), __builtin_amdgcn_mbcnt_lo((unsigned)me, 0u));
                    if (gt) dst[pos_gt + rg] = lane + 64 * i;
                    if (eq && eq_seen + re < need) dst[eq_base + eq_seen + re] = lane + 64 * i;
                    pos_gt += __builtin_popcountll(mg); eq_seen += __builtin_popcountll(me);
                }
            }
        } else {
            for (int e = tid; e < 1024; e += 512) { const int qi = e >> 4, k = e & 15; IDX[(((size_t)b * SEQ + qb * 64 + qi) * 2 + g) * 16 + k] = (k <= qb) ? k : -1; }
        }
    }
}

typedef long l64x2 __attribute__((ext_vector_type(2)));
struct SelBuf { l64x2 k[4]; l64x2 v[4]; };
__device__ __forceinline__ void sel_load(SelBuf& B, const unsigned char* Kb, const unsigned char* Vb, int jb, int cc, int q4) {
#pragma unroll
    for (int ht = 0; ht < 4; ++ht) { const int keyrow = jb * 64 + 32 * (ht >> 1) + 8 * (cc >> 2) + (cc & 3) + 4 * (ht & 1);
        B.k[ht] = *(const l64x2*)(Kb + (size_t)keyrow * 64 + q4 * 16); }
#pragma unroll
    for (int d = 0; d < 4; ++d) B.v[d] = *(const l64x2*)(Vb + ((size_t)jb * 64 + 16 * d + cc) * 64 + q4 * 16);
}
__device__ __forceinline__ void sel_load_any(SelBuf& B, const unsigned char* Kb, const unsigned char* Vb, const LAS unsigned char* fl, int jb, int cur, int cc, int q4) {
    const int slot = (jb == 0) ? 0 : ((jb == cur - 1) ? 1 : ((jb == cur) ? 2 : -1));
    if (slot < 0) { sel_load(B, Kb, Vb, jb, cc, q4); return; }
    const LAS unsigned char* fk = fl + slot * 8192; const LAS unsigned char* fv = fk + 4096;
#pragma unroll
    for (int ht = 0; ht < 4; ++ht) { const int keyrow = 32 * (ht >> 1) + 8 * (cc >> 2) + (cc & 3) + 4 * (ht & 1); B.k[ht] = *(const LAS l64x2*)(fk + keyrow * 64 + q4 * 16); }
#pragma unroll
    for (int d = 0; d < 4; ++d) B.v[d] = *(const LAS l64x2*)(fv + (16 * d + cc) * 64 + q4 * 16);
}
__device__ __forceinline__ long mk64(unsigned lo, unsigned hi) { const u32x2 v = {lo, hi}; return __builtin_bit_cast(long, v); }
__device__ __forceinline__ void sel_compute2(float& m, float& l, f32x4 (&o)[4], const long (&qf)[2], const SelBuf& A, const SelBuf& B, int kbA, int kbB, bool diagA, bool diagB, bool validB, int t, float c, int q4) {
    f32x4 s[8];
#pragma unroll
    for (int ht = 0; ht < 4; ++ht) { f32x4 a = {0.f, 0.f, 0.f, 0.f}, bq = {0.f, 0.f, 0.f, 0.f};
        a = __builtin_amdgcn_mfma_f32_16x16x32_fp8_fp8(A.k[ht].x, qf[0], a, 0, 0, 0);
        bq = __builtin_amdgcn_mfma_f32_16x16x32_fp8_fp8(B.k[ht].x, qf[0], bq, 0, 0, 0);
        a = __builtin_amdgcn_mfma_f32_16x16x32_fp8_fp8(A.k[ht].y, qf[1], a, 0, 0, 0);
        bq = __builtin_amdgcn_mfma_f32_16x16x32_fp8_fp8(B.k[ht].y, qf[1], bq, 0, 0, 0);
        s[ht] = a; s[4 + ht] = bq; }
    if (diagA | diagB | !validB) {
#pragma unroll
        for (int ht = 0; ht < 4; ++ht)
#pragma unroll
            for (int e = 0; e < 4; ++e) { const int ko = 32 * (ht >> 1) + 8 * q4 + 4 * (ht & 1) + e;
                if (diagA && kbA + ko > t) s[ht][e] = NEG;
                if (!validB || (diagB && kbB + ko > t)) s[4 + ht][e] = NEG; }
    }
    float mt = s[0][0];
#pragma unroll
    for (int ht = 0; ht < 8; ++ht)
#pragma unroll
        for (int e = 0; e < 4; ++e) mt = fmaxf(mt, s[ht][e]);
    mt = fmaxf(mt, __shfl_xor(mt, 16)); mt = fmaxf(mt, __shfl_xor(mt, 32));
    const float mn = fmaxf(m, mt);
    float alpha = 1.f;
    if (__any(mn != m)) {
        alpha = ex2((m - mn) * c);
#pragma unroll
        for (int d = 0; d < 4; ++d) o[d] = o[d] * alpha;
    }
    m = mn;
    f32x2_t ps2 = {0.f, 0.f}; const f32x2_t c2 = {c, c}, mn2 = {mn, mn}, e8 = {8.f, 8.f};
#pragma unroll
    for (int ht = 0; ht < 8; ++ht)
#pragma unroll
        for (int e = 0; e < 4; e += 2) { f32x2_t tt = {s[ht][e], s[ht][e + 1]}; tt = (tt - mn2) * c2 + e8; s[ht][e] = ex2(tt.x); s[ht][e + 1] = ex2(tt.y); const f32x2_t pp = {s[ht][e], s[ht][e + 1]}; ps2 += pp; }
    l = l * alpha + (ps2.x + ps2.y);
#pragma unroll
    for (int half = 0; half < 2; ++half) {
        const long pa = mk64(pk4_fp8(s[2 * half][0], s[2 * half][1], s[2 * half][2], s[2 * half][3]), pk4_fp8(s[2 * half + 1][0], s[2 * half + 1][1], s[2 * half + 1][2], s[2 * half + 1][3]));
        const long pbb = mk64(pk4_fp8(s[4 + 2 * half][0], s[4 + 2 * half][1], s[4 + 2 * half][2], s[4 + 2 * half][3]), pk4_fp8(s[4 + 2 * half + 1][0], s[4 + 2 * half + 1][1], s[4 + 2 * half + 1][2], s[4 + 2 * half + 1][3]));
#pragma unroll
        for (int d = 0; d < 4; ++d) {
            o[d] = __builtin_amdgcn_mfma_f32_16x16x32_fp8_fp8(half ? A.v[d].y : A.v[d].x, pa, o[d], 0, 0, 0);
            o[d] = __builtin_amdgcn_mfma_f32_16x16x32_fp8_fp8(half ? B.v[d].y : B.v[d].x, pbb, o[d], 0, 0, 0); }
    }
}
__device__ __forceinline__ void phase_sel(const Params& p, LAS unsigned char* lds, const bf16_t* Z, const float* G, const unsigned char* K8, const unsigned char* V8T, const float* ACC, const int* IDX, bf16_t* Mixed, int tid, int wid, int lane) {
    const int cc = lane & 15, q4 = lane >> 4, hh = cc & 3;
    const float c = 0.125f * LOG2E;
    const int gw = p.bid * 8 + wid, NGW = p.gdim * 8;
    int idx_n = -1, bg_staged = -1;
#define SEL_PREFETCH(pi) do { const int bg_ = (pi) >> 14, t_ = (pi) & (SEQ - 1), b_ = bg_ >> 1, g_ = bg_ & 1, cur_ = t_ >> 6; const size_t row_ = (size_t)b_ * SEQ + t_; \
        idx_n = (lane < 16) ? IDX[(row_ * 2 + g_) * 16 + lane] : -1; \
        } while (0)
    if (gw < 4 * SEQ) SEL_PREFETCH(gw);
    for (int pidx = gw; pidx < 4 * SEQ; pidx += NGW) {
        const int bg = pidx >> 14, t = pidx & (SEQ - 1), b = bg >> 1, g = bg & 1, cur = t >> 6;
        const size_t row = (size_t)b * SEQ + t;
        const int myidx = idx_n;
        const u32x4 qr0 = *(const u32x4*)(Z + row * ZLD + C_NSQ + (g * 4 + hh) * 64 + 8 * q4), qr1 = *(const u32x4*)(Z + row * ZLD + C_NSQ + (g * 4 + hh) * 64 + 32 + 8 * q4);
        u32x4 st[2];
#pragma unroll
        for (int i = 0; i < 2; ++i) { const int isv = tid >> 8, off = (tid & 255) * 16; const int fb = i == 0 ? (cur > 0 ? cur - 1 : 0) : cur;
            st[i] = *(const u32x4*)((isv ? V8T : K8) + (size_t)bg * SEQ * 64 + (size_t)fb * 4096 + off); }
        __syncthreads();
#pragma unroll
        for (int i = 0; i < 2; ++i) { const int isv = tid >> 8, off = (tid & 255) * 16; *(LAS u32x4*)(lds + (1 + i) * 8192 + isv * 4096 + off) = st[i]; }
        if (bg != bg_staged) { const int isv = tid >> 8, off = (tid & 255) * 16;
            *(LAS u32x4*)(lds + isv * 4096 + off) = *(const u32x4*)((isv ? V8T : K8) + (size_t)bg * SEQ * 64 + off); bg_staged = bg; }
        __syncthreads();
        if (pidx + NGW < 4 * SEQ) SEL_PREFETCH(pidx + NGW);
        long qf[2];
        { const u32x2 qa = bf8_to_fp8(qr0), qb2 = bf8_to_fp8(qr1); qf[0] = mk64(qa.x, qa.y); qf[1] = mk64(qb2.x, qb2.y); }
        const int nblk = __builtin_popcountll(__ballot(myidx >= 0));
        float m = NEG, l = 0.f; f32x4 o[4];
#pragma unroll
        for (int d = 0; d < 4; ++d) o[d] = (f32x4){0.f, 0.f, 0.f, 0.f};
        const unsigned char* Kb = K8 + (size_t)bg * SEQ * 64;
        const unsigned char* Vb = V8T + (size_t)bg * SEQ * 64;
        SelBuf b0, b1, b2, b3;
        const int last = nblk - 1;
#define SEL_IDX(i) __shfl(myidx, (i) < last ? (i) : last)
        int j0 = SEL_IDX(0), j1 = SEL_IDX(1), j2 = SEL_IDX(2), j3 = SEL_IDX(3);
        sel_load_any(b0, Kb, Vb, lds, j0, cur, cc, q4); sel_load_any(b1, Kb, Vb, lds, j1, cur, cc, q4); sel_load_any(b2, Kb, Vb, lds, j2, cur, cc, q4); sel_load_any(b3, Kb, Vb, lds, j3, cur, cc, q4);
        for (int k = 0; k < nblk; k += 4) {
            sel_compute2(m, l, o, qf, b0, b1, j0 * 64, j1 * 64, j0 == cur, j1 == cur, k + 1 < nblk, t, c, q4);
            if (k + 4 < nblk) { j0 = SEL_IDX(k + 4); j1 = SEL_IDX(k + 5); sel_load_any(b0, Kb, Vb, lds, j0, cur, cc, q4); sel_load_any(b1, Kb, Vb, lds, j1, cur, cc, q4); }
            if (k + 2 < nblk) sel_compute2(m, l, o, qf, b2, b3, j2 * 64, j3 * 64, j2 == cur, j3 == cur, k + 3 < nblk, t, c, q4);
            if (k + 6 < nblk) { j2 = SEL_IDX(k + 6); j3 = SEL_IDX(k + 7); sel_load_any(b2, Kb, Vb, lds, j2, cur, cc, q4); sel_load_any(b3, Kb, Vb, lds, j3, cur, cc, q4); }
        }
#undef SEL_IDX
        l += __shfl_xor(l, 16); l += __shfl_xor(l, 32);
        if (cc < 4) {
            const int head = g * 4 + cc;
            const float sc = (m > -1e29f) ? sigmoidf_(G[row * 32 + 8 + head * 3 + 1]) / l : 0.f;
#pragma unroll
            for (int d = 0; d < 4; ++d) { const int dv = 16 * d + 4 * q4; const f32x4 a = *(const f32x4*)(ACC + row * 512 + head * 64 + dv);
                u32x2 w; w.x = pk2(a.x + o[d][0] * sc, a.y + o[d][1] * sc); w.y = pk2(a.z + o[d][2] * sc, a.w + o[d][3] * sc);
                *(u32x2*)(Mixed + row * DM + 512 + head * 64 + dv) = w; }
        }
    }
#undef SEL_PREFETCH
}

__device__ __forceinline__ float ml_conv_silu(const bf16_t* Z, const float* conv, int b, int t, int zcol, int ch) {
    float a = 0.f;
#pragma unroll
    for (int j = 0; j < 4; ++j) { const int tt = t - 3 + j; if (tt >= 0) a += conv[j * 512 + ch] * bf2f(Z[((size_t)b * SEQ + tt) * ZLD + zcol]); }
    return a * sigmoidf_(a);
}
__device__ __forceinline__ void conv8_silu(const u32x4 (&zr)[4], const float* conv, int ch0, float scale, float (&o)[8]) {
    float acc[8];
#pragma unroll
    for (int i = 0; i < 8; ++i) acc[i] = 0.f;
#pragma unroll
    for (int j = 0; j < 4; ++j) { float z[8]; unpack8(zr[j], z); const f32x4 w0 = *(const f32x4*)(conv + j * 512 + ch0), w1 = *(const f32x4*)(conv + j * 512 + ch0 + 4);
#pragma unroll
        for (int i = 0; i < 4; ++i) { acc[i] += w0[i] * z[i]; acc[4 + i] += w1[i] * z[4 + i]; } }
#pragma unroll
    for (int i = 0; i < 8; ++i) o[i] = acc[i] * sigmoidf_(acc[i]) * scale;
}
__device__ __forceinline__ void load_taps(const bf16_t* Z, int b, int t, int zcol0, u32x4 (&zr)[4]) {
#pragma unroll
    for (int j = 0; j < 4; ++j) { const int tt = t - 3 + j; zr[j] = (tt >= 0) ? *(const u32x4*)(Z + ((size_t)b * SEQ + tt) * ZLD + zcol0) : (u32x4){0u, 0u, 0u, 0u}; }
}
constexpr int MLP = 72;
__device__ __forceinline__ void phase_ml_local(const Params& p, int layer, LAS unsigned char* lds, const bf16_t* Z, const float* G, float* CL, float* NL, float* GA, int tid, int wid, int lane) {
    LAS bf16_t* KsT = (LAS bf16_t*)lds;
    LAS bf16_t* VtW = KsT + 64 * MLP;
    LAS float* wl = (LAS float*)(VtW + 64 * MLP);
    const float* conv = p.ml_conv + layer * 4 * 512; const float* bias = p.ml_gate_bias + layer * 8;
    const int li = tid >> 3, d0 = (tid & 7) * 8, r = lane & 31, h = lane >> 5;
    u32x4 zk[4], zv = {0u, 0u, 0u, 0u};
#define MLL_LOAD(it_) do { const int bh_ = (it_) >> 8, b_ = bh_ >> 2, hd_ = bh_ & 3, t_ = ((it_) & 255) * 64 + li; load_taps(Z, b_, t_, C_MLK + hd_ * 64 + d0, zk); \
        zv = *(const u32x4*)(Z + ((size_t)b_ * SEQ + t_) * ZLD + C_MLV + hd_ * 64 + d0); } while (0)
    if (p.bid < 2048) MLL_LOAD(p.bid);
    for (int item = p.bid; item < 2048; item += p.gdim) {
        const int bh = item >> 8, ck = item & 255, b = bh >> 2, hd = bh & 3, t0 = ck * 64;
        __syncthreads();
        if (wid == 0) {
            const size_t row = (size_t)b * SEQ + t0 + lane;
            const float ig = G[row * 32 + hd] + bias[hd], lf = log_sigmoid(G[row * 32 + 4 + hd] + bias[4 + hd]);
            const float bs = wave_incl_scan(lf, lane), gsum = __shfl(bs, 63), a = gsum - bs + ig, amax = wave_max(a);
            wl[lane] = __expf(a - amax);
            if (lane == 0) { GA[(bh * 256 + ck) * 2] = gsum; GA[(bh * 256 + ck) * 2 + 1] = amax; }
        }
        __syncthreads();
        { float k8[8], v8[8]; conv8_silu(zk, conv, 256 + hd * 64 + d0, 0.125f, k8); unpack8(zv, v8); const float w = wl[li];
#pragma unroll
          for (int i = 0; i < 8; ++i) { KsT[(d0 + i) * MLP + li] = f2bf(k8[i]); VtW[(d0 + i) * MLP + li] = f2bf(v8[i] * w); } }
        __syncthreads();
        if (item + p.gdim < 2048) MLL_LOAD(item + p.gdim);
        if (wid < 4) {
            const int vi = wid >> 1, ki = wid & 1;
            f32x16 acc;
#pragma unroll
            for (int i = 0; i < 16; ++i) acc[i] = 0.f;
#pragma unroll
            for (int ks = 0; ks < 4; ++ks) { const bf16x8 av = *(const LAS bf16x8*)(VtW + (32 * vi + r) * MLP + 16 * ks + 8 * h), bk = *(const LAS bf16x8*)(KsT + (32 * ki + r) * MLP + 16 * ks + 8 * h);
                acc = __builtin_amdgcn_mfma_f32_32x32x16_bf16(av, bk, acc, 0, 0, 0); }
            float* dst = CL + (size_t)(bh * 256 + ck) * 4096 + 32 * ki + r;
#pragma unroll
            for (int i = 0; i < 16; ++i) dst[(32 * vi + rowi32(i, h)) * 64] = acc[i];
        } else if (wid == 4) {
            float n = 0.f;
            for (int l8 = 0; l8 < 64; l8 += 8) { float kk[8]; unpack8(*(const LAS u32x4*)(KsT + lane * MLP + l8), kk);
#pragma unroll
                for (int i = 0; i < 8; ++i) n += wl[l8 + i] * kk[i]; }
            NL[(size_t)(bh * 256 + ck) * 64 + lane] = n;
        }
    }
#undef MLL_LOAD
}
__device__ __forceinline__ void ml_scan_line(float* __restrict__ pc, size_t stride, const float* __restrict__ GA, float* __restrict__ MP, int bh, bool write_m) {
    float C = 0.f, m = 0.f;
    for (int c0 = 0; c0 < 256; c0 += 8) {
        float tmp[8], gs[8], am[8];
#pragma unroll
        for (int u = 0; u < 8; ++u) { tmp[u] = pc[(size_t)(c0 + u) * stride]; const float2 ga = *(const float2*)(GA + (bh * 256 + c0 + u) * 2); gs[u] = ga.x; am[u] = ga.y; }
#pragma unroll
        for (int u = 0; u < 8; ++u) { const int ck = c0 + u;
            const float mn = fmaxf(gs[u] + m, am[u]), sp = __expf(gs[u] + m - mn), sl = __expf(am[u] - mn);
            pc[(size_t)ck * stride] = C; if (write_m) MP[bh * 256 + ck] = m;
            C = sp * C + sl * tmp[u]; m = mn; }
    }
}
__device__ __forceinline__ void phase_ml_scan(const Params& p, float* CL, float* NL, const float* GA, float* MP, int wid, int lane) {
    if (wid < 2) {
        for (int gid = p.bid * 128 + wid * 64 + lane; gid < 32768; gid += p.gdim * 128) { const int bh = gid >> 12, e = gid & 4095;
            ml_scan_line(CL + (size_t)bh * 256 * 4096 + e, 4096, GA, MP, bh, e == 0); }
    } else if (wid == 2) {
        for (int gid = p.bid * 64 + lane; gid < 512; gid += p.gdim * 64) { const int bh = gid >> 6, k = gid & 63;
            ml_scan_line(NL + (size_t)bh * 256 * 64 + k, 64, GA, MP, bh, false); }
    }
}
__device__ __forceinline__ void phase_ml_out(const Params& p, int layer, LAS unsigned char* lds, const bf16_t* Z, const float* G, const float* CL, const float* NL, const float* MP, bf16_t* Mixed, int tid, int wid, int lane) {
    LAS bf16_t* Qs = (LAS bf16_t*)lds;
    LAS bf16_t* Ks = Qs + 64 * MLP;
    LAS bf16_t* Vt = Ks + 64 * MLP;
    LAS bf16_t* Cs = Vt + 64 * MLP;
    LAS bf16_t* Ql = Cs + 64 * MLP;
    LAS bf16_t* Kl = Ql + 64 * MLP;
    LAS float* bL = (LAS float*)(Kl + 64 * MLP); LAS float* uL = bL + 64; LAS float* mtL = uL + 64; LAS float* siL = mtL + 64; LAS float* npL = siL + 64;
    const float* conv = p.ml_conv + layer * 4 * 512; const float* bias = p.ml_gate_bias + layer * 8; const float* gain = p.ml_norm + layer * 256;
    const int li = tid >> 3, d0 = (tid & 7) * 8, r = lane & 31, h = lane >> 5;
    u32x4 zq[4], zk[4], zv = {0u, 0u, 0u, 0u}; f32x4 c0 = {0.f, 0.f, 0.f, 0.f}, c1 = c0;
#define MLO_LOAD(it_) do { const int bh_ = (it_) >> 8, ck_ = (it_) & 255, b_ = bh_ >> 2, hd_ = bh_ & 3, t_ = ck_ * 64 + li; \
        load_taps(Z, b_, t_, C_MLQ + hd_ * 64 + d0, zq); load_taps(Z, b_, t_, C_MLK + hd_ * 64 + d0, zk); zv = *(const u32x4*)(Z + ((size_t)b_ * SEQ + t_) * ZLD + C_MLV + hd_ * 64 + d0); \
        const float* cp_ = CL + (size_t)(bh_ * 256 + ck_) * 4096 + li * 64 + d0; c0 = *(const f32x4*)cp_; c1 = *(const f32x4*)(cp_ + 4); } while (0)
    if (p.bid < 2048) MLO_LOAD(p.bid);
    for (int item = p.bid; item < 2048; item += p.gdim) {
        const int bh = item >> 8, ck = item & 255, b = bh >> 2, hd = bh & 3, t0 = ck * 64;
        {
            float q8[8], k8[8]; conv8_silu(zq, conv, hd * 64 + d0, 1.f, q8); conv8_silu(zk, conv, 256 + hd * 64 + d0, 0.125f, k8);
            __syncthreads();
            u32x4 w; w.x = pk2(q8[0], q8[1]); w.y = pk2(q8[2], q8[3]); w.z = pk2(q8[4], q8[5]); w.w = pk2(q8[6], q8[7]); *(LAS u32x4*)(Qs + li * MLP + d0) = w;
            { float hi[8]; unpack8(w, hi); u32x4 wl2; wl2.x = pk2(q8[0] - hi[0], q8[1] - hi[1]); wl2.y = pk2(q8[2] - hi[2], q8[3] - hi[3]); wl2.z = pk2(q8[4] - hi[4], q8[5] - hi[5]); wl2.w = pk2(q8[6] - hi[6], q8[7] - hi[7]); *(LAS u32x4*)(Ql + li * MLP + d0) = wl2; }
            w.x = pk2(k8[0], k8[1]); w.y = pk2(k8[2], k8[3]); w.z = pk2(k8[4], k8[5]); w.w = pk2(k8[6], k8[7]); *(LAS u32x4*)(Ks + li * MLP + d0) = w;
            { float hi[8]; unpack8(w, hi); u32x4 wl2; wl2.x = pk2(k8[0] - hi[0], k8[1] - hi[1]); wl2.y = pk2(k8[2] - hi[2], k8[3] - hi[3]); wl2.z = pk2(k8[4] - hi[4], k8[5] - hi[5]); wl2.w = pk2(k8[6] - hi[6], k8[7] - hi[7]); *(LAS u32x4*)(Kl + li * MLP + d0) = wl2; }
            w.x = pk2(c0[0], c0[1]); w.y = pk2(c0[2], c0[3]); w.z = pk2(c1[0], c1[1]); w.w = pk2(c1[2], c1[3]); *(LAS u32x4*)(Cs + li * MLP + d0) = w;
            Vt[(d0 + 0) * MLP + li] = (bf16_t)(zv.x & 0xffffu); Vt[(d0 + 1) * MLP + li] = (bf16_t)(zv.x >> 16); Vt[(d0 + 2) * MLP + li] = (bf16_t)(zv.y & 0xffffu); Vt[(d0 + 3) * MLP + li] = (bf16_t)(zv.y >> 16);
            Vt[(d0 + 4) * MLP + li] = (bf16_t)(zv.z & 0xffffu); Vt[(d0 + 5) * MLP + li] = (bf16_t)(zv.z >> 16); Vt[(d0 + 6) * MLP + li] = (bf16_t)(zv.w & 0xffffu); Vt[(d0 + 7) * MLP + li] = (bf16_t)(zv.w >> 16);
        }
        if (tid >= 448) npL[tid - 448] = NL[(size_t)(bh * 256 + ck) * 64 + tid - 448];
        if (wid == 2) {
            const size_t row = (size_t)b * SEQ + t0 + lane;
            const float ig = G[row * 32 + hd] + bias[hd], lf = log_sigmoid(G[row * 32 + 4 + hd] + bias[4 + hd]);
            const float bs = wave_incl_scan(lf, lane), u = ig - bs, pm = wave_incl_scanmax(u, lane), mprev = MP[bh * 256 + ck];
            const float mt = bs + fmaxf(mprev, pm);
            bL[lane] = bs; uL[lane] = u; mtL[lane] = mt; siL[lane] = __expf(bs + mprev - mt);
        }
        __syncthreads();
        if (item + p.gdim < 2048) MLO_LOAD(item + p.gdim);
        if (wid < 2) {
            const int tl = 32 * wid + r;
            const size_t row = (size_t)b * SEQ + t0 + tl;
            bf16x8 qf[4], ql[4];
#pragma unroll
            for (int ks = 0; ks < 4; ++ks) { qf[ks] = *(const LAS bf16x8*)(Qs + tl * MLP + 16 * ks + 8 * h); ql[ks] = *(const LAS bf16x8*)(Ql + tl * MLP + 16 * ks + 8 * h); }
            const float bt = bL[tl] - mtL[tl], si = siL[tl];
            f32x16 n0, n1; float den = 0.f;
#pragma unroll
            for (int i = 0; i < 16; ++i) { n0[i] = 0.f; n1[i] = 0.f; }
#pragma unroll
            for (int sj = 0; sj < 2; ++sj) {
                if (sj > wid) continue;
                f32x16 sc;
#pragma unroll
                for (int i = 0; i < 16; ++i) sc[i] = 0.f;
#pragma unroll
                for (int ks = 0; ks < 4; ++ks) { const bf16x8 ak = *(const LAS bf16x8*)(Ks + (32 * sj + r) * MLP + 16 * ks + 8 * h), al = *(const LAS bf16x8*)(Kl + (32 * sj + r) * MLP + 16 * ks + 8 * h);
                    sc = __builtin_amdgcn_mfma_f32_32x32x16_bf16(al, qf[ks], sc, 0, 0, 0); sc = __builtin_amdgcn_mfma_f32_32x32x16_bf16(ak, ql[ks], sc, 0, 0, 0); sc = __builtin_amdgcn_mfma_f32_32x32x16_bf16(ak, qf[ks], sc, 0, 0, 0); }
                float wv[16];
#pragma unroll
                for (int i = 0; i < 16; ++i) { const int sidx = 32 * sj + rowi32(i, h); wv[i] = (sidx <= tl) ? __expf(bt + uL[sidx]) * sc[i] : 0.f; den += wv[i]; }
#pragma unroll
                for (int s2 = 0; s2 < 2; ++s2) {
                    const bf16x8 pb = pack8(wv[8 * s2 + 0], wv[8 * s2 + 1], wv[8 * s2 + 2], wv[8 * s2 + 3], wv[8 * s2 + 4], wv[8 * s2 + 5], wv[8 * s2 + 6], wv[8 * s2 + 7]);
                    const LAS bf16_t* vp = Vt + r * MLP + 32 * sj + 16 * s2 + 4 * h;
                    const u32x2 a0l = *(const LAS u32x2*)vp, a0h = *(const LAS u32x2*)(vp + 8);
                    const u32x2 a1l = *(const LAS u32x2*)(vp + 32 * MLP), a1h = *(const LAS u32x2*)(vp + 32 * MLP + 8);
                    const u32x4 v0 = {a0l.x, a0l.y, a0h.x, a0h.y}, v1 = {a1l.x, a1l.y, a1h.x, a1h.y};
                    n0 = __builtin_amdgcn_mfma_f32_32x32x16_bf16(__builtin_bit_cast(bf16x8, v0), pb, n0, 0, 0, 0);
                    n1 = __builtin_amdgcn_mfma_f32_32x32x16_bf16(__builtin_bit_cast(bf16x8, v1), pb, n1, 0, 0, 0);
                }
            }
            f32x16 c0, c1;
#pragma unroll
            for (int i = 0; i < 16; ++i) { c0[i] = 0.f; c1[i] = 0.f; }
#pragma unroll
            for (int ks = 0; ks < 4; ++ks) { const bf16x8 a0 = *(const LAS bf16x8*)(Cs + r * MLP + 16 * ks + 8 * h), a1 = *(const LAS bf16x8*)(Cs + (32 + r) * MLP + 16 * ks + 8 * h);
                c0 = __builtin_amdgcn_mfma_f32_32x32x16_bf16(a0, qf[ks], c0, 0, 0, 0); c1 = __builtin_amdgcn_mfma_f32_32x32x16_bf16(a1, qf[ks], c1, 0, 0, 0); }
            float nq = 0.f;
#pragma unroll
            for (int ks = 0; ks < 4; ++ks) { float qv[8], qw[8]; unpack8(__builtin_bit_cast(u32x4, qf[ks]), qv); unpack8(__builtin_bit_cast(u32x4, ql[ks]), qw);
#pragma unroll
                for (int j = 0; j < 8; ++j) nq += npL[16 * ks + 8 * h + j] * (qv[j] + qw[j]); }
            den += __shfl_xor(den, 32); nq += __shfl_xor(nq, 32);
            den += si * nq;
            const float inv = 1.f / fmaxf(fabsf(den), __expf(-mtL[tl]));
            float ss = 0.f;
#pragma unroll
            for (int g4 = 0; g4 < 4; ++g4) { const int dv = 8 * g4 + 4 * h;
                const u32x2 oa = *(const u32x2*)(Z + row * ZLD + C_MLO + hd * 64 + dv), ob = *(const u32x2*)(Z + row * ZLD + C_MLO + hd * 64 + 32 + dv);
                const float ga[4] = {__uint_as_float(oa.x << 16), __uint_as_float(oa.x & 0xffff0000u), __uint_as_float(oa.y << 16), __uint_as_float(oa.y & 0xffff0000u)};
                const float gb[4] = {__uint_as_float(ob.x << 16), __uint_as_float(ob.x & 0xffff0000u), __uint_as_float(ob.y << 16), __uint_as_float(ob.y & 0xffff0000u)};
#pragma unroll
                for (int e = 0; e < 4; ++e) { const int i = 4 * g4 + e;
                    n0[i] = sigmoidf_(ga[e]) * (n0[i] + si * c0[i]) * inv; n1[i] = sigmoidf_(gb[e]) * (n1[i] + si * c1[i]) * inv; ss += n0[i] * n0[i] + n1[i] * n1[i]; } }
            ss += __shfl_xor(ss, 32);
            const float rn = rsqrtf(ss * (1.f / 64.f) + EPSN);
            bf16_t* orow = Mixed + row * DM + hd * 64;
#pragma unroll
            for (int g4 = 0; g4 < 4; ++g4) { const int dv = 8 * g4 + 4 * h; const f32x4 ga = *(const f32x4*)(gain + hd * 64 + dv), gb = *(const f32x4*)(gain + hd * 64 + 32 + dv);
                u32x2 wa, wb;
                wa.x = pk2(n0[4 * g4 + 0] * rn * ga.x, n0[4 * g4 + 1] * rn * ga.y); wa.y = pk2(n0[4 * g4 + 2] * rn * ga.z, n0[4 * g4 + 3] * rn * ga.w);
                wb.x = pk2(n1[4 * g4 + 0] * rn * gb.x, n1[4 * g4 + 1] * rn * gb.y); wb.y = pk2(n1[4 * g4 + 2] * rn * gb.z, n1[4 * g4 + 3] * rn * gb.w);
                *(u32x2*)(orow + dv) = wa; *(u32x2*)(orow + 32 + dv) = wb; }
        }
    }
#undef MLO_LOAD
}

#define GAS __attribute__((address_space(1)))
#define XB_TMO      128
#define XB_XCNT(j)  (256  + 64 * (j))
#define XB_XSUB(j)  (1280 + 64 * (j))
#define XB_XGEN(j)  (2304 + 64 * (j))
#define XB_TOP      3328
#define XB_TOPGEN   3392
#define XCD_BAR_WORDS 3456
#define XB_SPIN_CAP (1u << 18)

__device__ __forceinline__ unsigned xb_ld(unsigned* p)              { return __hip_atomic_load(p, __ATOMIC_RELAXED, __HIP_MEMORY_SCOPE_AGENT); }
__device__ __forceinline__ unsigned xb_add(unsigned* p, unsigned v) { return __hip_atomic_fetch_add(p, v, __ATOMIC_RELAXED, __HIP_MEMORY_SCOPE_AGENT); }
__device__ __forceinline__ unsigned xb_xcc_id() { return (unsigned)__builtin_amdgcn_s_getreg((3 << 11) | 20) & 0xFu; }
#define XB_SPIN(cond, bar) do { unsigned _sp = 0; while (cond) { __builtin_amdgcn_s_sleep(1); \
    if ((++_sp & 255u) == 0u) { if (xb_ld(&(bar)[XB_TMO])) break; if (_sp > XB_SPIN_CAP) { atomicAdd(&(bar)[XB_TMO], 1u); break; } } } } while (0)

struct XcdBarrier {
    unsigned* bar; unsigned x;
    volatile LAS unsigned* st;
};

__device__ __forceinline__ XcdBarrier xcd_barrier_post(unsigned* bar, volatile LAS unsigned* st) {
    XcdBarrier b; b.bar = bar; b.x = xb_xcc_id(); b.st = st;
    if (threadIdx.x == 0) (void)xb_add(&bar[XB_XCNT(b.x)], 1u);
    return b;
}
__device__ __forceinline__ void xcd_barrier_complete(unsigned* bar, unsigned x, unsigned& nloc, unsigned& nx) {
    const unsigned G = gridDim.x * gridDim.y * gridDim.z;
    unsigned sum, cnt, mine, sp = 0u;
    for (;;) {
        sum = 0u; cnt = 0u; mine = 0u;
#pragma unroll
        for (unsigned j = 0; j < 16; ++j) { const unsigned c = xb_ld(&bar[XB_XCNT(j)]); sum += c; cnt += (c > 0u) ? 1u : 0u; mine = (j == x) ? c : mine; }
        if (sum == G) break;
        __builtin_amdgcn_s_sleep(1);
        if ((++sp & 255u) == 0u) { if (xb_ld(&bar[XB_TMO])) break; if (sp > XB_SPIN_CAP) { atomicAdd(&bar[XB_TMO], 1u); break; } }
    }
    nloc = mine > 0u ? mine : 1u; nx = cnt > 0u ? cnt : 1u;
}

__device__ __forceinline__ void xcd_barrier(const XcdBarrier& b) {
    asm volatile("s_waitcnt vmcnt(0)" ::: "memory");
    __syncthreads();
    if (threadIdx.x == 0) {
        unsigned* bar = b.bar;
        __builtin_amdgcn_s_waitcnt(0);
        unsigned nloc = b.st[0], nx = b.st[1];
        if (nloc == 0u) { xcd_barrier_complete(bar, b.x, nloc, nx); b.st[0] = nloc; b.st[1] = nx; }
        const unsigned old = xb_add(&bar[XB_XSUB(b.x)], 1u);
        const unsigned gen = old / nloc;
        if (old + 1u == (gen + 1u) * nloc) {
            __builtin_amdgcn_fence(__ATOMIC_RELEASE, "agent");
            asm volatile("s_waitcnt vmcnt(0)" ::: "memory");
            const unsigned og = xb_add(&bar[XB_TOP], 1u);
            const unsigned tg = og / nx;
            if (og + 1u == (tg + 1u) * nx) xb_add(&bar[XB_TOPGEN], 1u);
            else XB_SPIN(xb_ld(&bar[XB_TOPGEN]) == tg, bar);
            __builtin_amdgcn_fence(__ATOMIC_ACQUIRE, "agent");
            xb_add(&bar[XB_XGEN(b.x)], 1u);
            asm volatile("s_waitcnt vmcnt(0)" ::: "memory");
        } else {
            XB_SPIN(xb_ld(&bar[XB_XGEN(b.x)]) == gen, bar);
            __builtin_amdgcn_fence(__ATOMIC_ACQUIRE, "agent");
            asm volatile("s_waitcnt vmcnt(0)" ::: "memory");
        }
    }
    __syncthreads();
}

constexpr int LDS_BYTES = 147456;
constexpr int N_PHASES = 19;
typedef const __attribute__((address_space(4))) Params* KArgP;
__device__ __forceinline__ Params load_params(KArgP q) { Params P; P.x = q->x; P.norm1 = q->norm1; P.w_in = q->w_in; P.ml_conv = q->ml_conv; P.ml_gate_bias = q->ml_gate_bias; P.ml_norm = q->ml_norm;
    P.da_lambda = q->da_lambda; P.da_norm = q->da_norm; P.nsa_pe = q->nsa_pe; P.nsa_w1 = q->nsa_w1; P.nsa_w2 = q->nsa_w2; P.w_out = q->w_out; P.norm2 = q->norm2; P.w_ff1 = q->w_ff1; P.w_ff2 = q->w_ff2;
    P.final_norm = q->final_norm; P.out = q->out; P.ws = q->ws; P.ph_lo = q->ph_lo; P.ph_hi = q->ph_hi; P.coop = q->coop; P.pad = q->pad;
    int b_ = blockIdx.x, g_ = gridDim.x; asm volatile("" : "+s"(b_), "+s"(g_)); P.bid = b_; P.gdim = g_; return P; }
#define PHASE_ARGS KArgP q_ = kargs; asm volatile("" : "+s"(q_)); const Params P = load_params(q_); unsigned char* const ws = P.ws; (void)ws; int tid = tid0; asm volatile("" : "+v"(tid)); const int wid = __builtin_amdgcn_readfirstlane(tid >> 6), lane = tid & 63; (void)wid; (void)lane;
__global__ void __launch_bounds__(512, 2) hybrid_fwd(Params p_unused) {
    extern __shared__ __attribute__((aligned(16))) unsigned char lds_raw[];
    LAS unsigned char* lds = (LAS unsigned char*)lds_raw;
    cg::grid_group grid = cg::this_grid();
    const int tid0 = threadIdx.x;
    KArgP kargs = (KArgP)__builtin_amdgcn_kernarg_segment_ptr();
    const int ph_lo = kargs->ph_lo, ph_hi = kargs->ph_hi, coop = kargs->coop;
    volatile LAS unsigned* bar_st = (volatile LAS unsigned*)(lds + LDS_BYTES - 64);
    if (tid0 < 2) bar_st[tid0] = 0u;
    __syncthreads();
    XcdBarrier xbar; xbar.bar = nullptr; xbar.x = 0; xbar.st = bar_st;
    if (coop) xbar = xcd_barrier_post((unsigned*)(kargs->ws + WS_BAR), bar_st);
#define RUN(k) (ph_lo <= (k) && (k) < ph_hi)
#define SEAM(k) do { if (coop && (k) + 1 < ph_hi) { for (int rs_ = 0; rs_ < REP_SYNC; ++rs_) { if ((k) == 0) grid.sync(); else xcd_barrier(xbar); } } } while (0)
    if (RUN(0)) { for (int rep_ = 0; rep_ < REP_PRO; ++rep_) { __syncthreads(); PHASE_ARGS phase_prologue(P, lds, tid, wid, lane); } SEAM(0); }
#pragma unroll 1
    for (int layer = 0; layer < 2; ++layer) {
        const int pb = 1 + 9 * layer;
        if (RUN(pb + 0)) {
            { PHASE_ARGS
            pg8::Gemm g{(const bf16_t*)(ws + WS_HM), (const bf16_t*)(ws + WS_WIN) + (size_t)layer * ZLD * DM, NT, ZLD, DM}; pg8::StaticOrder S; S.init(NT, ZLD, P.gdim, P.bid);
            EpiIn E{(bf16_t*)(ws + WS_ZU), (float*)(ws + WS_G), layer == 0 ? (const float*)nullptr : (const float*)(ws + WS_SS2)};
            for (int rep_ = 0; rep_ < REP_GEMM; ++rep_) pg8::gemm_phase<EpiIn, pg8::StaticOrder, true, true>(lds, g, S, E); }
            SEAM(pb + 0);
        }
        if (RUN(pb + 1)) {
            for (int rep_ = 0; rep_ < REP_MLL; ++rep_) { __syncthreads(); PHASE_ARGS phase_ml_local(P, layer, lds, (const bf16_t*)(ws + WS_ZU), (const float*)(ws + WS_G), (float*)(ws + WS_CL), (float*)(ws + WS_NL), (float*)(ws + WS_GA), tid, wid, lane); }
            __syncthreads();
            for (int rep_ = 0; rep_ < REP_CMPRS; ++rep_) { __syncthreads(); PHASE_ARGS phase_compress(P, layer, lds, (const bf16_t*)(ws + WS_ZU), (bf16_t*)(ws + WS_KC), tid, wid, lane); }
            __syncthreads();
            for (int rep_ = 0; rep_ < REP_VST; ++rep_) { __syncthreads(); PHASE_ARGS phase_vst(P, lds, (const bf16_t*)(ws + WS_ZU), ws + WS_VST, ws + WS_VST + 4 * MiB, tid); }
            __syncthreads();
            for (int rep_ = 0; rep_ < REP_DA; ++rep_) { __syncthreads(); PHASE_ARGS phase_da(P, layer, lds, (const bf16_t*)(ws + WS_ZU), (bf16_t*)(ws + WS_HM), tid, wid, lane); }
            __syncthreads();
            for (int rep_ = 0; rep_ < REP_WIN; ++rep_) { __syncthreads(); PHASE_ARGS phase_win(P, lds, (const bf16_t*)(ws + WS_ZU), (const float*)(ws + WS_G), (bf16_t*)(ws + WS_ACCW), tid, wid, lane); }
            SEAM(pb + 1);
        }
        if (RUN(pb + 2)) {
            { PHASE_ARGS phase_cmp(P, lds, (const bf16_t*)(ws + WS_ZU), (const float*)(ws + WS_G), (const bf16_t*)(ws + WS_KC), (const bf16_t*)(ws + WS_ACCW), (float*)(ws + WS_ACC), (int*)(ws + WS_IDX),
                                   (float*)(ws + WS_CL), (float*)(ws + WS_NL), (const float*)(ws + WS_GA), (float*)(ws + WS_MP), (unsigned*)(ws + WS_QCTR) + 64 * layer, tid, wid, lane); }
            SEAM(pb + 2);
        }
        if (RUN(pb + 3)) {
            for (int rep_ = 0; rep_ < REP_MLO; ++rep_) { __syncthreads(); PHASE_ARGS phase_ml_out(P, layer, lds, (const bf16_t*)(ws + WS_ZU), (const float*)(ws + WS_G), (const float*)(ws + WS_CL), (const float*)(ws + WS_NL), (const float*)(ws + WS_MP), (bf16_t*)(ws + WS_HM), tid, wid, lane); }
            __syncthreads();
            for (int rep_ = 0; rep_ < REP_SEL; ++rep_) { __syncthreads(); PHASE_ARGS phase_sel(P, lds, (const bf16_t*)(ws + WS_ZU), (const float*)(ws + WS_G), ws + WS_VST, ws + WS_VST + 4 * MiB, (const float*)(ws + WS_ACC), (const int*)(ws + WS_IDX), (bf16_t*)(ws + WS_HM), tid, wid, lane); }
            SEAM(pb + 3);
        }
        if (RUN(pb + 4)) {
            { PHASE_ARGS
            pg8::Gemm g{(const bf16_t*)(ws + WS_HM), (const bf16_t*)(ws + WS_WOUT) + (size_t)layer * DM * DM, NT, DM, DM}; pg8::StaticOrder S; S.init(NT, DM, P.gdim, P.bid);
            EpiRes E{layer == 0 ? P.x : P.out, P.out, P.norm2 + layer * DM, (bf16_t*)(ws + WS_ACC), (float*)(ws + WS_SS1)};
            pg8::gemm_phase<EpiRes, pg8::StaticOrder, true, true>(lds, g, S, E); }
            SEAM(pb + 4);
        }
        if (RUN(pb + 6)) {
            { PHASE_ARGS
            pg8::Gemm g{(const bf16_t*)(ws + WS_ACC), (const bf16_t*)(ws + WS_WF1) + (size_t)layer * DM * DFF, NT, DFF, DM}; pg8::StaticOrder S; S.init(NT, DFF, P.gdim, P.bid);
            EpiRelu2 E{(bf16_t*)(ws + WS_ZU), (const float*)(ws + WS_SS1)};
            for (int rep_ = 0; rep_ < REP_GEMM; ++rep_) pg8::gemm_phase<EpiRelu2, pg8::StaticOrder, true, true>(lds, g, S, E); }
            SEAM(pb + 6);
        }
        if (RUN(pb + 7)) {
            { PHASE_ARGS
            pg8::Gemm g{(const bf16_t*)(ws + WS_ZU), (const bf16_t*)(ws + WS_WF2) + (size_t)layer * DM * DFF, NT, DM, DFF}; pg8::StaticOrder S; S.init(NT, DM, P.gdim, P.bid);
            EpiRes E{P.out, P.out, P.norm1 + DM, layer == 0 ? (bf16_t*)(ws + WS_HM) : (bf16_t*)nullptr, (float*)(ws + WS_SS2)};
            pg8::gemm_phase<EpiRes, pg8::StaticOrder, true, true>(lds, g, S, E); }
            SEAM(pb + 7);
        }
        if (RUN(pb + 8) && layer == 1) {
            { PHASE_ARGS
            for (int m = P.bid * 8 + wid; m < NT; m += P.gdim * 8) rms_row_f32(P.out + (size_t)m * DM, P.final_norm, lane); }
        }
    }
}

#ifndef N_LAUNCH_MODE
#define N_LAUNCH_MODE 1
#endif
extern "C" void kernel_launch(void* const* d_in, const int* in_sizes, int n_in, void* d_out, int out_size, void* d_ws, size_t ws_size, hipStream_t stream) {
    static int grid = 0;
    if (grid == 0) {
        int dev = 0, cus = 0, per_cu = 0;
        if (hipGetDevice(&dev) != hipSuccess || hipDeviceGetAttribute(&cus, hipDeviceAttributeMultiprocessorCount, dev) != hipSuccess) { fprintf(stderr, "kernel_launch: device query failed\n"); grid = -1; return; }
        if (hipFuncSetAttribute((const void*)hybrid_fwd, hipFuncAttributeMaxDynamicSharedMemorySize, LDS_BYTES) != hipSuccess) { fprintf(stderr, "kernel_launch: hipFuncSetAttribute failed\n"); grid = -1; return; }
        if (hipOccupancyMaxActiveBlocksPerMultiprocessor(&per_cu, (const void*)hybrid_fwd, 512, LDS_BYTES) != hipSuccess || per_cu < 1) { fprintf(stderr, "kernel_launch: occupancy query says %d\n", per_cu); per_cu = 1; }
        (void)hipGetLastError();
        grid = cus * 1;
        if (n_in != 16 || ws_size < WS_END) { fprintf(stderr, "kernel_launch: unexpected n_in %d / ws_size %zu\n", n_in, ws_size); }
    }
    if (grid < 0) return;
    Params p{};
    p.x = (const float*)d_in[0]; p.norm1 = (const float*)d_in[1]; p.w_in = (const float*)d_in[2]; p.ml_conv = (const float*)d_in[3]; p.ml_gate_bias = (const float*)d_in[4];
    p.ml_norm = (const float*)d_in[5]; p.da_lambda = (const float*)d_in[6]; p.da_norm = (const float*)d_in[7]; p.nsa_pe = (const float*)d_in[8]; p.nsa_w1 = (const float*)d_in[9];
    p.nsa_w2 = (const float*)d_in[10]; p.w_out = (const float*)d_in[11]; p.norm2 = (const float*)d_in[12]; p.w_ff1 = (const float*)d_in[13]; p.w_ff2 = (const float*)d_in[14];
    p.final_norm = (const float*)d_in[15]; p.out = (float*)d_out; p.ws = (unsigned char*)d_ws;
#if N_LAUNCH_MODE == 1
    if (hipMemsetAsync((char*)d_ws + WS_BAR, 0, 16384, stream) != hipSuccess) { fprintf(stderr, "kernel_launch: hipMemsetAsync of the barrier words failed\n"); return; }
    p.ph_lo = 0; p.ph_hi = N_PHASES; p.coop = 1; p.pad = 0; p.bid = 0; p.gdim = 0;
    void* args[] = {&p};
    hipError_t e = hipLaunchCooperativeKernel((const void*)hybrid_fwd, dim3(grid), dim3(512), args, LDS_BYTES, stream);
    if (e != hipSuccess) fprintf(stderr, "cooperative launch failed: %s (grid %d)\n", hipGetErrorString(e), grid);
#else
    for (int k = 0; k < N_PHASES; ++k) {
        p.ph_lo = k; p.ph_hi = k + 1; p.coop = 0; p.pad = 0; p.bid = 0; p.gdim = 0;
        hipLaunchKernelGGL(hybrid_fwd, dim3(grid), dim3(512), LDS_BYTES, stream, p);
    }
#endif
}
```

```cpp
#include <hip/hip_runtime.h>
#include <hip/hip_cooperative_groups.h>
#include <cstdio>
#include <cstdint>
namespace cg = cooperative_groups;
namespace pg8 {
#define PG8_LAS __attribute__((address_space(3)))
typedef unsigned short bf16_t;
typedef short bf16x8 __attribute__((ext_vector_type(8)));
typedef float f32x4 __attribute__((ext_vector_type(4)));
typedef unsigned u32x4 __attribute__((ext_vector_type(4)));
constexpr int BM = 256, BK = 64, HALF = 128, HTB = HALF * BK * 2  , STAGE_BYTES = 8 * HTB, NXCD = 8, WGM = 8;

__host__ __device__ __forceinline__ int lds_byte(int r, int c) { const int st = (r >> 4) * 2 + (c >> 5), rr = r & 15, cc = c & 31, ob = rr * 64 + cc * 2; return st * 1024 + (ob ^ (((ob >> 9) & 1) << 5)); }
__host__ __device__ __forceinline__ void stage_rc(int b, int& R, int& C) { const int st = b / 1024, sb = b % 1024, swz = sb ^ (((sb >> 9) & 1) << 5); R = (st >> 1) * 16 + swz / 64; C = (st & 1) * 32 + (swz % 64) / 2; }
__host__ __device__ __forceinline__ int perm32(int rho) { const int n = rho >> 4, i = rho & 15; return 8 * (i >> 2) + 4 * n + (i & 3); }

struct Unit { int pm, pn; };
struct Gemm { const bf16_t* A; const bf16_t* Bt; int M, N, K; };

struct StaticOrder {
    int nM, nN, nwg, G, c;
    __host__ __device__ void init(int M, int N, int G_, int c_) { nM = M / BM; nN = N / BM; nwg = nM * nN; G = G_; c = c_; }
    __host__ __device__ bool next(int i, Unit& u) const {
        const long L = (long)i * G + c; if (L >= nwg) return false;
        int wgid = (int)L; { const int q = nwg / NXCD, r = nwg % NXCD, xcd = wgid % NXCD, off = wgid / NXCD; wgid = (xcd < r ? xcd * (q + 1) : r * (q + 1) + (xcd - r) * q) + off; }
        const int nig = WGM * nN, gid = wgid / nig, fm = gid * WGM, gsz = (nM - fm) < WGM ? (nM - fm) : WGM;
        u.pm = fm + ((wgid % nig) % gsz); u.pn = (wgid % nig) / gsz; return true;
    }
    __device__ __forceinline__ void a_ready(const Unit&) const {}
    __device__ __forceinline__ void done(const Unit&) const {}
};

__device__ __forceinline__ unsigned cvt_pk_bf16(float lo, float hi) { unsigned r; asm volatile("v_cvt_pk_bf16_f32 %0, %1, %2" : "=v"(r) : "v"(lo), "v"(hi)); return r; }
template <class Epi, class Sched, bool ALIGN_EPI = false, bool SP2 = false>
__device__ __forceinline__ void gemm_phase(PG8_LAS unsigned char* lds, const Gemm g, const Sched& S, const Epi& E) {
    int tid = threadIdx.x; asm volatile("" : "+v"(tid)); const int wid = __builtin_amdgcn_readfirstlane(tid >> 6), lane = tid & 63, wr = wid >> 2, wc = wid & 3, fr = lane & 15, fq = lane >> 4;
    const int K = g.K, nt = K / BK;
    unsigned voffA[2], voffB[2];
#pragma unroll
    for (int i = 0; i < 2; ++i) { int R, C; stage_rc(tid * 16 + i * 8192, R, C); const int Rb = Epi::PERM ? ((R & ~31) + perm32(R & 31)) : R;
        voffA[i] = (unsigned)(R * K + C) * 2u; voffB[i] = (unsigned)(Rb * K + C) * 2u; }
    const size_t kstep = (size_t)(BK * 2);
    const size_t hstep = (size_t)HALF * K * 2;
    const size_t tstep = 2 * hstep;
    const unsigned ldsw = (unsigned)wid * 1024u;
    const int aoff = lds_byte(wr * 64 + fr, fq * 8), boff = lds_byte(wc * 32 + fr, fq * 8);
#define PG8_SA(b, h) (((b) * 2 + (h)) * HTB)
#define PG8_SB(b, h) ((4 + (b) * 2 + (h)) * HTB)
#define PG8_STAGE(bufoff, gbase, voff) do { _Pragma("unroll") for (int _i = 0; _i < 2; ++_i) \
        __builtin_amdgcn_global_load_lds((const unsigned*)((const char*)(gbase) + (voff)[_i]), (PG8_LAS unsigned*)(lds + (bufoff) + ldsw + _i * 8192), 16, 0, 0); } while (0)
#define PG8_LDA(dst, b, h) do { _Pragma("unroll") for (int m = 0; m < 4; ++m) _Pragma("unroll") for (int k = 0; k < 2; ++k) dst[m][k] = *(const PG8_LAS bf16x8*)(lds + PG8_SA(b, h) + aoff + m * 2048 + k * 1024); } while (0)
#define PG8_LDB(dst, b, h) do { _Pragma("unroll") for (int n = 0; n < 2; ++n) _Pragma("unroll") for (int k = 0; k < 2; ++k) dst[n][k] = *(const PG8_LAS bf16x8*)(lds + PG8_SB(b, h) + boff + n * 2048 + k * 1024); } while (0)
#define PG8_MMA(ai, bj, At, Bt) do { __builtin_amdgcn_s_setprio(1); _Pragma("unroll") for (int m = 0; m < 4; ++m) _Pragma("unroll") for (int n = 0; n < 2; ++n) _Pragma("unroll") for (int k = 0; k < 2; ++k) \
        acc[ai][bj][m][n] = __builtin_amdgcn_mfma_f32_16x16x32_bf16(Bt[n][k], At[m][k], acc[ai][bj][m][n], 0, 0, 0); __builtin_amdgcn_s_setprio(0); } while (0)
#define PG8_WAIT_V(n) asm volatile("s_waitcnt vmcnt(" #n ")" ::: "memory")
#define PG8_WAIT_L(n) asm volatile("s_waitcnt lgkmcnt(" #n ")" ::: "memory")
#define PG8_BAR __builtin_amdgcn_s_barrier()
#define PG8_SCHED __builtin_amdgcn_sched_barrier(0)
    Unit cur, nxt; int ui = 0;
    if (!S.next(0, cur)) return;
    f32x4 acc[2][2][4][2];
#pragma unroll
    for (int a = 0; a < 2; ++a)
#pragma unroll
        for (int b = 0; b < 2; ++b)
#pragma unroll
            for (int m = 0; m < 4; ++m)
#pragma unroll
                for (int n = 0; n < 2; ++n) acc[a][b][m][n] = (f32x4){0.f, 0.f, 0.f, 0.f};
    bf16x8 At[4][2], B0[2][2], B1[2][2];
    const char* cA = (const char*)g.A + (size_t)cur.pm * tstep; const char* cB = (const char*)g.Bt + (size_t)cur.pn * tstep;
    S.a_ready(cur);
    if constexpr (SP2) {
        PG8_STAGE(PG8_SB(0, 0), cB, voffB); PG8_STAGE(PG8_SB(0, 1), cB + hstep, voffB); PG8_STAGE(PG8_SA(0, 0), cA, voffA); PG8_STAGE(PG8_SA(0, 1), cA + hstep, voffA);
        if (wr == 1) PG8_BAR;
        PG8_WAIT_V(2); PG8_BAR;
        PG8_STAGE(PG8_SB(1, 0), cB + kstep, voffB); PG8_STAGE(PG8_SA(1, 0), cA + kstep, voffA); PG8_STAGE(PG8_SB(1, 1), cB + hstep + kstep, voffB);
        PG8_WAIT_V(6); PG8_BAR;
    } else {
        PG8_STAGE(PG8_SB(0, 0), cB, voffB); PG8_STAGE(PG8_SA(0, 0), cA, voffA); PG8_STAGE(PG8_SB(0, 1), cB + hstep, voffB); PG8_STAGE(PG8_SA(0, 1), cA + hstep, voffA);
        if (wr == 1) PG8_BAR;
        PG8_WAIT_V(4); PG8_BAR;
        PG8_STAGE(PG8_SB(1, 0), cB + kstep, voffB); PG8_STAGE(PG8_SA(1, 0), cA + kstep, voffA); PG8_STAGE(PG8_SB(1, 1), cB + hstep + kstep, voffB);
        PG8_WAIT_V(6); PG8_BAR;
    }
    for (;;) {
        const bool has_next = S.next(ui + 1, nxt);
        const char* nA = has_next ? (const char*)g.A + (size_t)nxt.pm * tstep : cA; const char* nB = has_next ? (const char*)g.Bt + (size_t)nxt.pn * tstep : cB;
        for (int t = 0; t < nt; t += 2) {
            const bool last = (t == nt - 2);
            const char* a1 = cA + (size_t)(t + 1) * kstep;
            const char* a2 = last ? nA : cA + (size_t)(t + 2) * kstep; const char* b2 = last ? nB : cB + (size_t)(t + 2) * kstep;
            const char* a3 = a2 + kstep; const char* b3 = b2 + kstep;
            if (last && has_next) S.a_ready(nxt);
            if constexpr (SP2) {
            PG8_LDB(B0, 0, 0); PG8_LDB(B1, 0, 1); PG8_SCHED; PG8_LDA(At, 0, 0); PG8_STAGE(PG8_SA(1, 1), a1 + hstep, voffA);
            PG8_WAIT_V(8); PG8_WAIT_L(0); PG8_BAR; PG8_MMA(0, 0, At, B0); PG8_MMA(0, 1, At, B1); PG8_BAR; PG8_SCHED;
            PG8_LDA(At, 0, 1); PG8_STAGE(PG8_SB(0, 0), b2, voffB); PG8_STAGE(PG8_SB(0, 1), b2 + hstep, voffB); PG8_STAGE(PG8_SA(0, 0), a2, voffA);
            PG8_WAIT_V(8); PG8_WAIT_L(0); PG8_BAR; PG8_MMA(1, 0, At, B0); PG8_MMA(1, 1, At, B1); PG8_BAR; PG8_SCHED;
            PG8_LDB(B0, 1, 0); PG8_LDB(B1, 1, 1); PG8_SCHED; PG8_LDA(At, 1, 0); PG8_STAGE(PG8_SA(0, 1), a2 + hstep, voffA);
            PG8_WAIT_V(8); PG8_WAIT_L(0); PG8_BAR; PG8_MMA(0, 0, At, B0); PG8_MMA(0, 1, At, B1); PG8_BAR; PG8_SCHED;
            PG8_LDA(At, 1, 1); PG8_STAGE(PG8_SB(1, 0), b3, voffB); PG8_STAGE(PG8_SB(1, 1), b3 + hstep, voffB); PG8_STAGE(PG8_SA(1, 0), a3, voffA);
            PG8_WAIT_V(8); PG8_WAIT_L(0); PG8_BAR; PG8_MMA(1, 0, At, B0); PG8_MMA(1, 1, At, B1); PG8_BAR; PG8_SCHED;
            } else {
            PG8_LDB(B0, 0, 0); PG8_SCHED; PG8_LDA(At, 0, 0); PG8_STAGE(PG8_SA(1, 1), a1 + hstep, voffA);
            PG8_WAIT_L(8); PG8_BAR; PG8_WAIT_L(0); PG8_MMA(0, 0, At, B0); PG8_BAR; PG8_SCHED;
            PG8_LDB(B1, 0, 1); PG8_STAGE(PG8_SB(0, 0), b2, voffB);
            PG8_BAR; PG8_WAIT_L(0); PG8_MMA(0, 1, At, B1); PG8_BAR;
            PG8_LDA(At, 0, 1); PG8_STAGE(PG8_SA(0, 0), a2, voffA);
            PG8_BAR; PG8_WAIT_L(0); PG8_MMA(1, 0, At, B0); PG8_BAR; PG8_SCHED;
            PG8_STAGE(PG8_SB(0, 1), b2 + hstep, voffB);
            PG8_WAIT_V(6); PG8_BAR; PG8_MMA(1, 1, At, B1); PG8_BAR;
            PG8_LDB(B0, 1, 0); PG8_SCHED; PG8_LDA(At, 1, 0); PG8_STAGE(PG8_SA(0, 1), a2 + hstep, voffA);
            PG8_WAIT_L(8); PG8_BAR; PG8_WAIT_L(0); PG8_MMA(0, 0, At, B0); PG8_BAR; PG8_SCHED;
            PG8_LDB(B1, 1, 1); PG8_STAGE(PG8_SB(1, 0), b3, voffB);
            PG8_BAR; PG8_WAIT_L(0); PG8_MMA(0, 1, At, B1); PG8_BAR;
            PG8_LDA(At, 1, 1); PG8_STAGE(PG8_SA(1, 0), a3, voffA);
            PG8_BAR; PG8_WAIT_L(0); PG8_MMA(1, 0, At, B0); PG8_BAR; PG8_SCHED;
            PG8_STAGE(PG8_SB(1, 1), b3 + hstep, voffB);
            PG8_WAIT_V(6); PG8_BAR; PG8_MMA(1, 1, At, B1); PG8_BAR;
            }
        }
        if constexpr (ALIGN_EPI) { if (wr == 0) PG8_BAR; }
        if constexpr (!Epi::AFTER_DRAIN) { E(acc, cur, wr, wc, fr, fq); S.done(cur); }
        if (!has_next) break;
#pragma unroll
        for (int a = 0; a < 2; ++a)
#pragma unroll
            for (int b = 0; b < 2; ++b)
#pragma unroll
                for (int m = 0; m < 4; ++m)
#pragma unroll
                    for (int n = 0; n < 2; ++n) acc[a][b][m][n] = (f32x4){0.f, 0.f, 0.f, 0.f};
        cur = nxt; cA = nA; cB = nB; ++ui;
        if constexpr (ALIGN_EPI) { if (wr == 1) PG8_BAR; }
    }
    PG8_WAIT_V(0);
    if constexpr (!ALIGN_EPI) { if (wr == 0) PG8_BAR; }
    PG8_BAR;
    if constexpr (Epi::AFTER_DRAIN) { E.fused(acc, cur, wr, wc, fr, fq, lds, wid, lane); S.done(cur); }
#undef PG8_SA
#undef PG8_SB
#undef PG8_STAGE
#undef PG8_LDA
#undef PG8_LDB
#undef PG8_MMA
#undef PG8_WAIT_V
#undef PG8_WAIT_L
#undef PG8_BAR
#undef PG8_SCHED
}
}
#ifndef REP_CMP
#define REP_CMP 1
#endif
#ifndef REP_SYNC
#define REP_SYNC 1
#endif
#ifndef REP_PRO
#define REP_PRO 1
#endif
#ifndef REP_NORM
#define REP_NORM 1
#endif
#ifndef REP_GEMM
#define REP_GEMM 1
#endif
#ifndef REP_MLL
#define REP_MLL 1
#endif
#ifndef REP_CMPRS
#define REP_CMPRS 1
#endif
#ifndef REP_VST
#define REP_VST 1
#endif
#ifndef REP_DA
#define REP_DA 1
#endif
#ifndef REP_WIN
#define REP_WIN 1
#endif
#ifndef REP_MLO
#define REP_MLO 1
#endif
#ifndef REP_SEL
#define REP_SEL 1
#endif
#ifndef DBG_NOCMPACC
#define DBG_NOCMPACC 0
#endif
#ifndef DBG_SCRUB
#define DBG_SCRUB 0
#endif
#ifndef DBG_SCRUBKC
#define DBG_SCRUBKC 0
#endif
#ifndef DBG_SCRUBZ
#define DBG_SCRUBZ 0
#endif
#ifndef DBG_NOSEL
#define DBG_NOSEL 0
#endif
#ifndef DBG_MASK
#define DBG_MASK 31
#endif

#define LAS __attribute__((address_space(3)))
typedef unsigned short bf16_t;
typedef short bf16x8 __attribute__((ext_vector_type(8)));
typedef short bf16x4 __attribute__((ext_vector_type(4)));
typedef float f32x4 __attribute__((ext_vector_type(4)));
typedef float f32x16 __attribute__((ext_vector_type(16)));
typedef unsigned u32x4 __attribute__((ext_vector_type(4)));
typedef unsigned u32x2 __attribute__((ext_vector_type(2)));

constexpr int NB = 2, SEQ = 16384, NT = NB * SEQ, DM = 1024, ZLD = 3328, DFF = 4096, INC = 3104;
constexpr int C_MLQ = 0, C_MLK = 256, C_MLV = 512, C_MLO = 768, C_DAQ = 1024, C_DAK = 1280, C_DAV = 1536, C_NSQ = 1792,
              C_KC = 2304, C_VC = 2432, C_KS = 2560, C_VS = 2688, C_KW = 2816, C_VW = 2944;
constexpr float EPSN = 1e-6f, NEG = -1e30f, LOG2E = 1.4426950408889634f;
constexpr size_t MiB = 1u << 20;
constexpr size_t WS_ZU = 0;
constexpr size_t WS_ACCW = 208 * MiB;
constexpr size_t WS_HM = 256 * MiB;
constexpr size_t WS_CL = 320 * MiB;
constexpr size_t WS_ACC = 352 * MiB;
constexpr size_t WS_WIN = 416 * MiB;
constexpr size_t WS_WOUT = WS_WIN + 2 * (size_t)ZLD * 1024 * 2;
constexpr size_t WS_WF1 = WS_WOUT + 2 * (size_t)1024 * 1024 * 2;
constexpr size_t WS_WF2 = WS_WF1 + 2 * (size_t)4096 * 1024 * 2;
constexpr size_t WS_WC1 = WS_WF2 + 2 * (size_t)4096 * 1024 * 2;
constexpr size_t WS_WC2 = WS_WC1 + 4 * (size_t)256 * 2048 * 2;
constexpr size_t WS_G = 472 * MiB;
constexpr size_t WS_IDX = 476 * MiB;
constexpr size_t WS_VST = 480 * MiB;
constexpr size_t WS_KC = 488 * MiB;
constexpr size_t WS_NL = 489 * MiB;
constexpr size_t WS_GA = 490 * MiB;
constexpr size_t WS_MP = WS_GA + 65536;
constexpr size_t WS_CB = WS_MP + 65536;
constexpr size_t WS_QCTR = WS_CB + 8192;
constexpr size_t WS_SS1 = 492 * MiB;
constexpr size_t WS_SS2 = 494 * MiB;
constexpr size_t WS_BAR = 498 * MiB;
constexpr size_t WS_END = 499 * MiB;
static_assert(WS_WC2 + 4 * 64 * 256 * 2 <= WS_G, "ws map");

struct Params {
    const float* x; const float* norm1; const float* w_in; const float* ml_conv; const float* ml_gate_bias; const float* ml_norm;
    const float* da_lambda; const float* da_norm; const float* nsa_pe; const float* nsa_w1; const float* nsa_w2; const float* w_out;
    const float* norm2; const float* w_ff1; const float* w_ff2; const float* final_norm;
    float* out; unsigned char* ws;
    int ph_lo, ph_hi, coop, pad, bid, gdim;
};

__device__ __forceinline__ float bf2f(bf16_t v) { return __uint_as_float((unsigned)v << 16); }
typedef __bf16 bf16v2_t __attribute__((ext_vector_type(2)));
typedef float f32x2_t __attribute__((ext_vector_type(2)));
__device__ __forceinline__ unsigned pk2(float lo, float hi) { const f32x2_t v = {lo, hi}; const bf16v2_t b = __builtin_convertvector(v, bf16v2_t); return __builtin_bit_cast(unsigned, b); }
__device__ __forceinline__ bf16_t f2bf(float f) { return (bf16_t)(pk2(f, 0.f) & 0xffffu); }
__device__ __forceinline__ float ex2(float x) { return __builtin_amdgcn_exp2f(x); }
__device__ __forceinline__ float sigmoidf_(float x) { return 1.f / (1.f + __expf(-x)); }
__device__ __forceinline__ float wave_sum(float v) {
#pragma unroll
    for (int o = 1; o < 64; o <<= 1) v += __shfl_xor(v, o);
    return v;
}
__device__ __forceinline__ float wave_max(float v) {
#pragma unroll
    for (int o = 1; o < 64; o <<= 1) v = fmaxf(v, __shfl_xor(v, o));
    return v;
}
__device__ __forceinline__ float wave_incl_scan(float v, int lane) {
#pragma unroll
    for (int o = 1; o < 64; o <<= 1) { const float t = __shfl_up(v, o); if (lane >= o) v += t; }
    return v;
}
__device__ __forceinline__ float wave_incl_scanmax(float v, int lane) {
#pragma unroll
    for (int o = 1; o < 64; o <<= 1) { const float t = __shfl_up(v, o); if (lane >= o) v = fmaxf(v, t); }
    return v;
}
__device__ __forceinline__ float log_sigmoid(float x) { return fminf(x, 0.f) - log1pf(__expf(-fabsf(x))); }
__device__ __forceinline__ bf16x8 pack8(float a0, float a1, float a2, float a3, float a4, float a5, float a6, float a7) {
    u32x4 u; u.x = pk2(a0, a1); u.y = pk2(a2, a3); u.z = pk2(a4, a5); u.w = pk2(a6, a7); return __builtin_bit_cast(bf16x8, u);
}
__device__ __forceinline__ void unpack8(u32x4 v, float (&o)[8]) {
    o[0] = __uint_as_float(v.x << 16); o[1] = __uint_as_float(v.x & 0xffff0000u); o[2] = __uint_as_float(v.y << 16); o[3] = __uint_as_float(v.y & 0xffff0000u);
    o[4] = __uint_as_float(v.z << 16); o[5] = __uint_as_float(v.z & 0xffff0000u); o[6] = __uint_as_float(v.w << 16); o[7] = __uint_as_float(v.w & 0xffff0000u);
}
__device__ __forceinline__ int rowi32(int i, int h) { return (i & 3) + 8 * (i >> 2) + 4 * h; }

__device__ __forceinline__ float row_rstd(const float* SS, int row) {
    if (!SS) return 1.f;
    const f32x4* sp = (const f32x4*)(SS + (size_t)row * 16); const f32x4 a = sp[0], b = sp[1], c = sp[2], d = sp[3];
    const float t = ((a.x + a.y) + (a.z + a.w)) + ((b.x + b.y) + (b.z + b.w)) + ((c.x + c.y) + (c.z + c.w)) + ((d.x + d.y) + (d.z + d.w));
    return rsqrtf(t * (1.f / DM) + EPSN);
}
struct EpiIn {
    static constexpr bool PERM = true, AFTER_DRAIN = false;
    bf16_t* Z; float* G; const float* SS;
    __device__ __forceinline__ void operator()(const f32x4 (&acc)[2][2][4][2], const pg8::Unit& u, int wr, int wc, int fr, int fq) const {
        const int row0 = u.pm * 256 + wr * 64 + fr;
        if (u.pn < 12) {
            const int col0 = u.pn * 256 + wc * 32 + 8 * fq;
#pragma unroll
            for (int ai = 0; ai < 2; ++ai)
#pragma unroll
                for (int m = 0; m < 4; ++m) { const int row = row0 + ai * 128 + m * 16; const float rs = row_rstd(SS, row); bf16_t* rowp = Z + (size_t)row * ZLD + col0;
#pragma unroll
                    for (int bj = 0; bj < 2; ++bj) { const f32x4 v0 = acc[ai][bj][m][0] * rs, v1 = acc[ai][bj][m][1] * rs; u32x4 w;
                        w.x = pk2(v0[0], v0[1]); w.y = pk2(v0[2], v0[3]); w.z = pk2(v1[0], v1[1]); w.w = pk2(v1[2], v1[3]);
                        *(u32x4*)(rowp + bj * 128) = w; } }
        } else if (wc == 0) {
#pragma unroll
            for (int ai = 0; ai < 2; ++ai)
#pragma unroll
                for (int m = 0; m < 4; ++m) { const int row = row0 + ai * 128 + m * 16; const float rs = row_rstd(SS, row); float* gp = G + (size_t)row * 32 + 8 * fq;
                    *(f32x4*)gp = acc[ai][0][m][0] * rs; *(f32x4*)(gp + 4) = acc[ai][0][m][1] * rs; }
        }
    }
};
struct EpiRes {
    static constexpr bool PERM = false, AFTER_DRAIN = false;
    const float* base; float* out; const float* gain; bf16_t* XG; float* SS;
    __device__ __forceinline__ void operator()(const f32x4 (&acc)[2][2][4][2], const pg8::Unit& u, int wr, int wc, int fr, int fq) const {
        const int row0 = u.pm * 256 + wr * 64 + fr, col0 = u.pn * 256 + wc * 32 + 4 * fq;
        f32x4 g00 = {0.f, 0.f, 0.f, 0.f}, g01 = g00, g10 = g00, g11 = g00;
        if (XG) { g00 = *(const f32x4*)(gain + col0); g01 = *(const f32x4*)(gain + col0 + 16); g10 = *(const f32x4*)(gain + col0 + 128); g11 = *(const f32x4*)(gain + col0 + 144); }
#pragma unroll
        for (int ai = 0; ai < 2; ++ai)
#pragma unroll
            for (int m = 0; m < 4; ++m) { const int row = row0 + ai * 128 + m * 16; const size_t off = (size_t)row * DM + col0;
                const f32x4 b00 = *(const f32x4*)(base + off), b01 = *(const f32x4*)(base + off + 16), b10 = *(const f32x4*)(base + off + 128), b11 = *(const f32x4*)(base + off + 144);
                const f32x4 o00 = b00 + acc[ai][0][m][0], o01 = b01 + acc[ai][0][m][1], o10 = b10 + acc[ai][1][m][0], o11 = b11 + acc[ai][1][m][1];
                *(f32x4*)(out + off) = o00; *(f32x4*)(out + off + 16) = o01; *(f32x4*)(out + off + 128) = o10; *(f32x4*)(out + off + 144) = o11;
                if (XG) {
                    const f32x4 x00 = o00 * g00, x01 = o01 * g01, x10 = o10 * g10, x11 = o11 * g11; u32x2 w;
                    w.x = pk2(x00[0], x00[1]); w.y = pk2(x00[2], x00[3]); *(u32x2*)(XG + off) = w;
                    w.x = pk2(x01[0], x01[1]); w.y = pk2(x01[2], x01[3]); *(u32x2*)(XG + off + 16) = w;
                    w.x = pk2(x10[0], x10[1]); w.y = pk2(x10[2], x10[3]); *(u32x2*)(XG + off + 128) = w;
                    w.x = pk2(x11[0], x11[1]); w.y = pk2(x11[2], x11[3]); *(u32x2*)(XG + off + 144) = w;
                    const f32x4 q = o00 * o00 + o01 * o01 + o10 * o10 + o11 * o11;
                    float ss = (q[0] + q[1]) + (q[2] + q[3]);
                    ss += __shfl_xor(ss, 16); ss += __shfl_xor(ss, 32);
                    if (fq == 0) SS[(size_t)row * 16 + u.pn * 4 + wc] = ss;
                }
                asm volatile("" ::: "memory"); }
    }
};
struct EpiRelu2 {
    static constexpr bool PERM = true, AFTER_DRAIN = false;
    bf16_t* U; const float* SS;
    __device__ __forceinline__ void operator()(const f32x4 (&acc)[2][2][4][2], const pg8::Unit& u, int wr, int wc, int fr, int fq) const {
        const int row0 = u.pm * 256 + wr * 64 + fr, col0 = u.pn * 256 + wc * 32 + 8 * fq;
#pragma unroll
        for (int ai = 0; ai < 2; ++ai)
#pragma unroll
            for (int m = 0; m < 4; ++m) { const int row = row0 + ai * 128 + m * 16; const float rs = row_rstd(SS, row), rs2 = rs * rs; bf16_t* rowp = U + (size_t)row * DFF + col0;
#pragma unroll
                for (int bj = 0; bj < 2; ++bj) { f32x4 v0 = acc[ai][bj][m][0], v1 = acc[ai][bj][m][1];
#pragma unroll
                    for (int e = 0; e < 4; ++e) { const float a = fmaxf(v0[e], 0.f), b = fmaxf(v1[e], 0.f); v0[e] = a * a * rs2; v1[e] = b * b * rs2; }
                    u32x4 w; w.x = pk2(v0[0], v0[1]); w.y = pk2(v0[2], v0[3]); w.z = pk2(v1[0], v1[1]); w.w = pk2(v1[2], v1[3]);
                    *(u32x4*)(rowp + bj * 128) = w; } }
    }
};

__device__ __forceinline__ int map_in_col(int c) { return c < 1024 ? c : (c < 1032 ? 3072 + (c - 1024) : (c < 3080 ? c - 8 : c)); }
template <bool MAPIN>
__device__ __forceinline__ void transpose_item(const float* W, int K, int N, bf16_t* WT, LAS float* scr, int item, int lane) {
    const int nblk = N / 32, kb = item / nblk, nb = item % nblk, k0 = 64 * kb, n0 = 32 * nb;
#pragma unroll 8
    for (int i = 0; i < 32; ++i) { const int kk = 2 * i + (lane >> 5); scr[kk * 33 + (lane & 31)] = W[(size_t)(k0 + kk) * N + n0 + (lane & 31)]; }
    asm volatile("s_waitcnt lgkmcnt(0)" ::: "memory");
    const int c = lane & 7;
#pragma unroll
    for (int j = 0; j < 4; ++j) { const int n = (lane >> 3) + 8 * j; const LAS float* s = scr + (8 * c) * 33 + n;
        u32x4 o; o.x = pk2(s[0 * 33], s[1 * 33]); o.y = pk2(s[2 * 33], s[3 * 33]); o.z = pk2(s[4 * 33], s[5 * 33]); o.w = pk2(s[6 * 33], s[7 * 33]);
        const int dr = MAPIN ? map_in_col(n0 + n) : (n0 + n);
        *(u32x4*)(WT + (size_t)dr * K + k0 + 8 * c) = o; }
    asm volatile("s_waitcnt lgkmcnt(0)" ::: "memory");
}
__device__ __forceinline__ void rms_row_bf16(const float* xrow, const float* g, bf16_t* orow, int lane) {
    f32x4 v[4]; float s = 0.f;
#pragma unroll
    for (int j = 0; j < 4; ++j) { v[j] = ((const f32x4*)xrow)[lane + 64 * j]; s += (v[j].x * v[j].x + v[j].y * v[j].y) + (v[j].z * v[j].z + v[j].w * v[j].w); }
    const float r = rsqrtf(wave_sum(s) * (1.f / DM) + EPSN);
#pragma unroll
    for (int j = 0; j < 4; ++j) { const f32x4 gv = ((const f32x4*)g)[lane + 64 * j]; u32x2 o; o.x = pk2(v[j].x * r * gv.x, v[j].y * r * gv.y); o.y = pk2(v[j].z * r * gv.z, v[j].w * r * gv.w);
        ((u32x2*)orow)[lane + 64 * j] = o; }
}
__device__ __forceinline__ void rms_row_f32(float* xrow, const float* g, int lane) {
    f32x4 v[4]; float s = 0.f;
#pragma unroll
    for (int j = 0; j < 4; ++j) { v[j] = ((const f32x4*)xrow)[lane + 64 * j]; s += (v[j].x * v[j].x + v[j].y * v[j].y) + (v[j].z * v[j].z + v[j].w * v[j].w); }
    const float r = rsqrtf(wave_sum(s) * (1.f / DM) + EPSN);
#pragma unroll
    for (int j = 0; j < 4; ++j) { const f32x4 gv = ((const f32x4*)g)[lane + 64 * j]; ((f32x4*)xrow)[lane + 64 * j] = v[j] * r * gv; }
}
__device__ __forceinline__ void phase_norm_bf16(const Params& p, const float* x, const float* g, bf16_t* H, int wid, int lane) {
    for (int m = p.bid * 8 + wid; m < NT; m += p.gdim * 8) rms_row_bf16(x + (size_t)m * DM, g, H + (size_t)m * DM, lane);
}

__device__ __forceinline__ void phase_prologue(const Params& p, LAS unsigned char* lds, int tid, int wid, int lane) {
    unsigned char* ws = p.ws;
    LAS float* scr = (LAS float*)(lds + wid * 16384);
    const int gw = p.bid * 8 + wid, NGW = p.gdim * 8;
    constexpr int I_IN = 16 * 97, I_OUT = 16 * 32, I_F1 = 16 * 128, I_F2 = 64 * 32, I_C1 = 32 * 8, I_C2 = 4 * 2;
    constexpr int PER = I_IN + I_OUT + I_F1 + I_F2 + 2 * I_C1 + 2 * I_C2;
    for (int it = gw; it < 2 * PER; it += NGW) {
        const int l = it / PER; int r = it % PER;
        if (r < I_IN) { transpose_item<true>(p.w_in + (size_t)l * DM * INC, DM, INC, (bf16_t*)(ws + WS_WIN) + (size_t)l * ZLD * DM, scr, r, lane); continue; } r -= I_IN;
        if (r < I_OUT) { transpose_item<false>(p.w_out + (size_t)l * DM * DM, DM, DM, (bf16_t*)(ws + WS_WOUT) + (size_t)l * DM * DM, scr, r, lane); continue; } r -= I_OUT;
        if (r < I_F1) { transpose_item<false>(p.w_ff1 + (size_t)l * DM * DFF, DM, DFF, (bf16_t*)(ws + WS_WF1) + (size_t)l * DM * DFF, scr, r, lane); continue; } r -= I_F1;
        if (r < I_F2) { transpose_item<false>(p.w_ff2 + (size_t)l * DM * DFF, DFF, DM, (bf16_t*)(ws + WS_WF2) + (size_t)l * DM * DFF, scr, r, lane); continue; } r -= I_F2;
        if (r < 2 * I_C1) { const int kv = r / I_C1; transpose_item<false>(p.nsa_w1 + (size_t)(l * 2 + kv) * 2048 * 256, 2048, 256, (bf16_t*)(ws + WS_WC1) + (size_t)(l * 2 + kv) * 256 * 2048, scr, r % I_C1, lane); continue; } r -= 2 * I_C1;
        { const int kv = r / I_C2; transpose_item<false>(p.nsa_w2 + (size_t)(l * 2 + kv) * 256 * 64, 256, 64, (bf16_t*)(ws + WS_WC2) + (size_t)(l * 2 + kv) * 64 * 256, scr, r % I_C2, lane); }
    }
    __syncthreads();
    for (int it = p.bid; it < 16; it += p.gdim) {
        const int lk = it >> 2, n = (it & 3) * 64 + lane; const float* pe = p.nsa_pe + (size_t)lk * 2048 + wid * 256; const float* w1 = p.nsa_w1 + ((size_t)lk * 2048 + wid * 256) * 256 + n;
        float s0 = 0.f, s1 = 0.f, s2 = 0.f, s3 = 0.f;
#pragma unroll 4
        for (int kk = 0; kk < 256; kk += 4) { s0 += pe[kk] * w1[(size_t)kk * 256]; s1 += pe[kk + 1] * w1[(size_t)(kk + 1) * 256]; s2 += pe[kk + 2] * w1[(size_t)(kk + 2) * 256]; s3 += pe[kk + 3] * w1[(size_t)(kk + 3) * 256]; }
        LAS float* red = (LAS float*)lds;
        __syncthreads();
        red[wid * 64 + lane] = (s0 + s1) + (s2 + s3);
        __syncthreads();
        if (wid == 0) { float t = 0.f;
#pragma unroll
            for (int w = 0; w < 8; ++w) t += red[w * 64 + lane];
            ((float*)(ws + WS_CB))[lk * 256 + n] = t; }
    }
    __syncthreads();
    if (p.bid == 0 && tid < 2) ((unsigned*)(ws + WS_QCTR))[64 * tid] = 0u;
    phase_norm_bf16(p, p.x, p.norm1, (bf16_t*)(ws + WS_HM), wid, lane);
}

__device__ __forceinline__ bf16x8 scale_frag(bf16x8 q, float c) { float v[8]; unpack8(__builtin_bit_cast(u32x4, q), v); return pack8(v[0] * c, v[1] * c, v[2] * c, v[3] * c, v[4] * c, v[5] * c, v[6] * c, v[7] * c); }
constexpr int KP = 72, VP = 72;
#define TL_DECL const int kkey_ = tid >> 3, kch_ = tid & 7, vkey_ = tid & 63, vch_ = tid >> 6; u32x4 kr_ = {0u, 0u, 0u, 0u}, vr_ = {0u, 0u, 0u, 0u};
#define TL_FETCH(Kg, kpitch, Vg, vpitch, t) do { kr_ = *(const u32x4*)((Kg) + (size_t)(64 * (t) + kkey_) * (kpitch) + kch_ * 8); \
        vr_ = *(const u32x4*)((Vg) + (size_t)(64 * (t) + vkey_) * (vpitch) + vch_ * 8); } while (0)
constexpr int TLB = 64 * KP + 64 * VP;
#define TL_WRITE(bi) do { LAS bf16_t* ks_ = Ks0 + (bi) * TLB; LAS bf16_t* vt_ = ks_ + 64 * KP; *(LAS u32x4*)(ks_ + kkey_ * KP + kch_ * 8) = kr_; \
        vt_[(vch_ * 8 + 0) * VP + vkey_] = (bf16_t)(vr_.x & 0xffffu); vt_[(vch_ * 8 + 1) * VP + vkey_] = (bf16_t)(vr_.x >> 16); \
        vt_[(vch_ * 8 + 2) * VP + vkey_] = (bf16_t)(vr_.y & 0xffffu); vt_[(vch_ * 8 + 3) * VP + vkey_] = (bf16_t)(vr_.y >> 16); \
        vt_[(vch_ * 8 + 4) * VP + vkey_] = (bf16_t)(vr_.z & 0xffffu); vt_[(vch_ * 8 + 5) * VP + vkey_] = (bf16_t)(vr_.z >> 16); \
        vt_[(vch_ * 8 + 6) * VP + vkey_] = (bf16_t)(vr_.w & 0xffffu); vt_[(vch_ * 8 + 7) * VP + vkey_] = (bf16_t)(vr_.w >> 16); } while (0)
#define TL_BEGIN(Kg, kpitch, Vg, vpitch, t0, t1) do { TL_FETCH(Kg, kpitch, Vg, vpitch, t0); TL_WRITE(0); __syncthreads(); if ((t0) + 1 < (t1)) TL_FETCH(Kg, kpitch, Vg, vpitch, (t0) + 1); } while (0)
#define TL_NEXT(Kg, kpitch, Vg, vpitch, t, t1, bi) do { if ((t) + 1 < (t1)) { TL_WRITE((bi) ^ 1); if ((t) + 2 < (t1)) TL_FETCH(Kg, kpitch, Vg, vpitch, (t) + 2); } __syncthreads(); } while (0)

template <int ND>
__device__ __forceinline__ f32x16 qk_sub(const bf16x8 (&qf)[ND], const LAS bf16_t* Ks, int kr0, int kc0, int r, int h) {
    f32x16 s;
#pragma unroll
    for (int i = 0; i < 16; ++i) s[i] = 0.f;
#pragma unroll
    for (int ks = 0; ks < ND; ++ks) { const bf16x8 a = *(const LAS bf16x8*)(Ks + (kr0 + r) * KP + kc0 + 16 * ks + 8 * h); s = __builtin_amdgcn_mfma_f32_32x32x16_bf16(a, qf[ks], s, 0, 0, 0); }
    return s;
}
template <int MODE> __device__ __forceinline__ bool key_ok(int key, int qpos) {
    if (MODE == 0) return key <= qpos;
    if (MODE == 1) return (key <= qpos) && (key > qpos - 512);
    return 16 * key + 31 <= qpos;
}
template <int ND, int MODE>
__device__ __forceinline__ void attn_sub(float& m, float& l, f32x16& o0, f32x16& o1, const bf16x8 (&qf)[ND], const LAS bf16_t* Ks, const LAS bf16_t* Vt,
                                         int kr0, int kc0, int key0, int qpos, float c, bool need_mask, int r, int h) {
    f32x16 s = qk_sub<ND>(qf, Ks, kr0, kc0, r, h);
    if (need_mask) {
#pragma unroll
        for (int i = 0; i < 16; ++i) { const int key = key0 + rowi32(i, h); s[i] = key_ok<MODE>(key, qpos) ? s[i] : NEG; }
    }
    float mt = s[0];
#pragma unroll
    for (int i = 1; i < 16; ++i) mt = fmaxf(mt, s[i]);
    mt = fmaxf(mt, __shfl_xor(mt, 32));
    const float mn = fmaxf(m, mt);
    float alpha = 1.f;
    if (__any(mn != m)) {
        alpha = ex2((m - mn) * c);
#pragma unroll
        for (int i = 0; i < 16; ++i) { o0[i] *= alpha; o1[i] *= alpha; }
    }
    m = mn;
    float pv[16]; f32x2_t ps2 = {0.f, 0.f}; const f32x2_t c2 = {c, c}, mn2 = {mn, mn};
#pragma unroll
    for (int i = 0; i < 8; ++i) { f32x2_t tt = {s[2 * i], s[2 * i + 1]}; tt = (tt - mn2) * c2; pv[2 * i] = ex2(tt.x); pv[2 * i + 1] = ex2(tt.y); const f32x2_t pp = {pv[2 * i], pv[2 * i + 1]}; ps2 += pp; }
    l = l * alpha + (ps2.x + ps2.y);
#pragma unroll
    for (int s2 = 0; s2 < 2; ++s2) {
        const bf16x8 pb = pack8(pv[8 * s2 + 0], pv[8 * s2 + 1], pv[8 * s2 + 2], pv[8 * s2 + 3], pv[8 * s2 + 4], pv[8 * s2 + 5], pv[8 * s2 + 6], pv[8 * s2 + 7]);
        const LAS bf16_t* vp = Vt + r * VP + kr0 + 16 * s2 + 4 * h;
        const u32x2 a0l = *(const LAS u32x2*)vp, a0h = *(const LAS u32x2*)(vp + 8);
        const u32x2 a1l = *(const LAS u32x2*)(vp + 32 * VP), a1h = *(const LAS u32x2*)(vp + 32 * VP + 8);
        u32x4 a0 = {a0l.x, a0l.y, a0h.x, a0h.y}, a1 = {a1l.x, a1l.y, a1h.x, a1h.y};
        o0 = __builtin_amdgcn_mfma_f32_32x32x16_bf16(__builtin_bit_cast(bf16x8, a0), pb, o0, 0, 0, 0);
        o1 = __builtin_amdgcn_mfma_f32_32x32x16_bf16(__builtin_bit_cast(bf16x8, a1), pb, o1, 0, 0, 0);
    }
}

__device__ __forceinline__ void attn_sub_x2(float& m1, float& l1, f32x16& oa0, f32x16& oa1, float& m2, float& l2, f32x16& ob0, f32x16& ob1,
                                            const bf16x8 (&qf1)[2], const bf16x8 (&qf2)[2], const LAS bf16_t* Ks, const LAS bf16_t* Vt, int kr0, int key0, int qpos, float c, bool need_mask, int r, int h) {
    f32x16 s1 = qk_sub<2>(qf1, Ks, kr0, 0, r, h), s2 = qk_sub<2>(qf2, Ks, kr0, 32, r, h);
    if (need_mask) {
#pragma unroll
        for (int i = 0; i < 16; ++i) { const bool ok = (key0 + rowi32(i, h)) <= qpos; s1[i] = ok ? s1[i] : NEG; s2[i] = ok ? s2[i] : NEG; }
    }
    float mt1 = s1[0], mt2 = s2[0];
#pragma unroll
    for (int i = 1; i < 16; ++i) { mt1 = fmaxf(mt1, s1[i]); mt2 = fmaxf(mt2, s2[i]); }
    mt1 = fmaxf(mt1, __shfl_xor(mt1, 32)); mt2 = fmaxf(mt2, __shfl_xor(mt2, 32));
    const float mn1 = fmaxf(m1, mt1), mn2 = fmaxf(m2, mt2);
    float al1 = 1.f, al2 = 1.f;
    if (__any((mn1 != m1) | (mn2 != m2))) {
        al1 = ex2((m1 - mn1) * c); al2 = ex2((m2 - mn2) * c);
#pragma unroll
        for (int i = 0; i < 16; ++i) { oa0[i] *= al1; oa1[i] *= al1; ob0[i] *= al2; ob1[i] *= al2; }
    }
    m1 = mn1; m2 = mn2;
    float p1[16], p2[16]; f32x2_t a1 = {0.f, 0.f}, a2 = {0.f, 0.f}; const f32x2_t c2 = {c, c}, mA = {mn1, mn1}, mB = {mn2, mn2};
#pragma unroll
    for (int i = 0; i < 8; ++i) { f32x2_t t1 = {s1[2 * i], s1[2 * i + 1]}, t2 = {s2[2 * i], s2[2 * i + 1]}; t1 = (t1 - mA) * c2; t2 = (t2 - mB) * c2;
        p1[2 * i] = ex2(t1.x); p1[2 * i + 1] = ex2(t1.y); p2[2 * i] = ex2(t2.x); p2[2 * i + 1] = ex2(t2.y);
        const f32x2_t u1 = {p1[2 * i], p1[2 * i + 1]}, u2 = {p2[2 * i], p2[2 * i + 1]}; a1 += u1; a2 += u2; }
    l1 = l1 * al1 + (a1.x + a1.y); l2 = l2 * al2 + (a2.x + a2.y);
#pragma unroll
    for (int s2i = 0; s2i < 2; ++s2i) {
        const bf16x8 pb1 = pack8(p1[8 * s2i + 0], p1[8 * s2i + 1], p1[8 * s2i + 2], p1[8 * s2i + 3], p1[8 * s2i + 4], p1[8 * s2i + 5], p1[8 * s2i + 6], p1[8 * s2i + 7]);
        const bf16x8 pb2 = pack8(p2[8 * s2i + 0], p2[8 * s2i + 1], p2[8 * s2i + 2], p2[8 * s2i + 3], p2[8 * s2i + 4], p2[8 * s2i + 5], p2[8 * s2i + 6], p2[8 * s2i + 7]);
        const LAS bf16_t* vp = Vt + r * VP + kr0 + 16 * s2i + 4 * h;
        const u32x2 a0l = *(const LAS u32x2*)vp, a0h = *(const LAS u32x2*)(vp + 8);
        const u32x2 a1l = *(const LAS u32x2*)(vp + 32 * VP), a1h = *(const LAS u32x2*)(vp + 32 * VP + 8);
        const u32x4 v0 = {a0l.x, a0l.y, a0h.x, a0h.y}, v1 = {a1l.x, a1l.y, a1h.x, a1h.y};
        oa0 = __builtin_amdgcn_mfma_f32_32x32x16_bf16(__builtin_bit_cast(bf16x8, v0), pb1, oa0, 0, 0, 0);
        ob0 = __builtin_amdgcn_mfma_f32_32x32x16_bf16(__builtin_bit_cast(bf16x8, v0), pb2, ob0, 0, 0, 0);
        oa1 = __builtin_amdgcn_mfma_f32_32x32x16_bf16(__builtin_bit_cast(bf16x8, v1), pb1, oa1, 0, 0, 0);
        ob1 = __builtin_amdgcn_mfma_f32_32x32x16_bf16(__builtin_bit_cast(bf16x8, v1), pb2, ob1, 0, 0, 0);
    }
}

__device__ __forceinline__ void attn_fast_x2(float mr1, f32x16& L1, f32x16& oa0, f32x16& oa1, float mr2, f32x16& L2, f32x16& ob0, f32x16& ob1,
                                             const bf16x8 (&qf1)[2], const bf16x8 (&qf2)[2], const LAS bf16_t* Ks, const LAS bf16_t* Vt, int kr0, int key0, int qpos, bool need_mask, int r, int h) {
    f32x16 s1, s2;
#pragma unroll
    for (int i = 0; i < 16; ++i) { s1[i] = -mr1; s2[i] = -mr2; }
#pragma unroll
    for (int ks = 0; ks < 2; ++ks) { const bf16x8 a1 = *(const LAS bf16x8*)(Ks + (kr0 + r) * KP + 16 * ks + 8 * h), a2 = *(const LAS bf16x8*)(Ks + (kr0 + r) * KP + 32 + 16 * ks + 8 * h);
        s1 = __builtin_amdgcn_mfma_f32_32x32x16_bf16(a1, qf1[ks], s1, 0, 0, 0); s2 = __builtin_amdgcn_mfma_f32_32x32x16_bf16(a2, qf2[ks], s2, 0, 0, 0); }
    if (need_mask) {
#pragma unroll
        for (int i = 0; i < 16; ++i) { const bool ok = (key0 + rowi32(i, h)) <= qpos; s1[i] = ok ? s1[i] : NEG; s2[i] = ok ? s2[i] : NEG; }
    }
    float p1[16], p2[16];
#pragma unroll
    for (int i = 0; i < 16; ++i) { p1[i] = ex2(s1[i]); p2[i] = ex2(s2[i]); }
    const u32x4 onesu = {0x3f803f80u, 0x3f803f80u, 0x3f803f80u, 0x3f803f80u}; const bf16x8 ones = __builtin_bit_cast(bf16x8, onesu);
#pragma unroll
    for (int s2i = 0; s2i < 2; ++s2i) {
        const bf16x8 pb1 = pack8(p1[8 * s2i + 0], p1[8 * s2i + 1], p1[8 * s2i + 2], p1[8 * s2i + 3], p1[8 * s2i + 4], p1[8 * s2i + 5], p1[8 * s2i + 6], p1[8 * s2i + 7]);
        const bf16x8 pb2 = pack8(p2[8 * s2i + 0], p2[8 * s2i + 1], p2[8 * s2i + 2], p2[8 * s2i + 3], p2[8 * s2i + 4], p2[8 * s2i + 5], p2[8 * s2i + 6], p2[8 * s2i + 7]);
        const LAS bf16_t* vp = Vt + r * VP + kr0 + 16 * s2i + 4 * h;
        const u32x2 a0l = *(const LAS u32x2*)vp, a0h = *(const LAS u32x2*)(vp + 8);
        const u32x2 a1l = *(const LAS u32x2*)(vp + 32 * VP), a1h = *(const LAS u32x2*)(vp + 32 * VP + 8);
        const u32x4 v0 = {a0l.x, a0l.y, a0h.x, a0h.y}, v1 = {a1l.x, a1l.y, a1h.x, a1h.y};
        oa0 = __builtin_amdgcn_mfma_f32_32x32x16_bf16(__builtin_bit_cast(bf16x8, v0), pb1, oa0, 0, 0, 0);
        ob0 = __builtin_amdgcn_mfma_f32_32x32x16_bf16(__builtin_bit_cast(bf16x8, v0), pb2, ob0, 0, 0, 0);
        oa1 = __builtin_amdgcn_mfma_f32_32x32x16_bf16(__builtin_bit_cast(bf16x8, v1), pb1, oa1, 0, 0, 0);
        ob1 = __builtin_amdgcn_mfma_f32_32x32x16_bf16(__builtin_bit_cast(bf16x8, v1), pb2, ob1, 0, 0, 0);
        L1 = __builtin_amdgcn_mfma_f32_32x32x16_bf16(ones, pb1, L1, 0, 0, 0);
        L2 = __builtin_amdgcn_mfma_f32_32x32x16_bf16(ones, pb2, L2, 0, 0, 0);
    }
}

__device__ __forceinline__ void phase_da(const Params& p, int layer, LAS unsigned char* lds, const bf16_t* Z, bf16_t* Mixed, int tid, int wid, int lane) {
    LAS bf16_t* Ks0 = (LAS bf16_t*)lds;
    const int r = lane & 31, h = lane >> 5;
    const float lam_init = 0.8f - 0.6f * expf(-0.3f * (float)layer);
    float lam;
    { const float* lf = p.da_lambda + layer * 128; float s1 = 0.f, s2 = 0.f;
      for (int i = 0; i < 32; ++i) { s1 += lf[i] * lf[32 + i]; s2 += lf[64 + i] * lf[96 + i]; }
      lam = expf(s1) - expf(s2) + lam_init; }
    const float c = 0.17677669529663687f * LOG2E;
    const float* gain = p.da_norm + layer * 256;
    TL_DECL
    for (int pr = p.bid; pr < 256; pr += p.gdim) {
        const int b = pr >> 7, hd = (pr >> 5) & 3, qa = pr & 31;
        const bf16_t* Kg = Z + (size_t)b * SEQ * ZLD + C_DAK + hd * 64;
        const bf16_t* Vg = Z + (size_t)b * SEQ * ZLD + C_DAV + hd * 64;
        for (int half = 0; half < 2; ++half) {
            const int qb = half ? 63 - qa : qa;
            const int q0w = qb * 256 + 32 * wid, qpos = q0w + r;
            const size_t row = (size_t)b * SEQ + qpos;
            bf16x8 qf1[2], qf2[2];
#pragma unroll
            for (int ks = 0; ks < 2; ++ks) { qf1[ks] = scale_frag(*(const bf16x8*)(Z + row * ZLD + C_DAQ + hd * 64 + 16 * ks + 8 * h), c); qf2[ks] = scale_frag(*(const bf16x8*)(Z + row * ZLD + C_DAQ + hd * 64 + 32 + 16 * ks + 8 * h), c); }
            float m1 = NEG, l1 = 0.f, m2 = NEG, l2 = 0.f; f32x16 oa0, oa1, ob0, ob1;
#pragma unroll
            for (int i = 0; i < 16; ++i) { oa0[i] = 0.f; oa1[i] = 0.f; ob0[i] = 0.f; ob1[i] = 0.f; }
            const int ntile = 4 * (qb + 1);
            f32x16 L1, L2;
            TL_BEGIN(Kg, ZLD, Vg, ZLD, 0, ntile);
            for (int t = 0, bi = 0; t < ntile; ++t, bi ^= 1) {
                const LAS bf16_t* Ks = Ks0 + bi * TLB; const LAS bf16_t* Vt = Ks + 64 * KP;
#pragma unroll
                for (int sub = 0; sub < 2; ++sub) {
                    const int k0 = 64 * t + 32 * sub;
                    if (k0 > q0w + 31) continue;
                    const bool nm = (k0 + 31 > q0w);
                    if (t == 0 && sub == 0) {
                        attn_sub_x2(m1, l1, oa0, oa1, m2, l2, ob0, ob1, qf1, qf2, Ks, Vt, 0, k0, qpos, 1.0f, nm, r, h);
                        l1 += __shfl_xor(l1, 32); l2 += __shfl_xor(l2, 32);
#pragma unroll
                        for (int i = 0; i < 16; ++i) { L1[i] = l1; L2[i] = l2; }
                    } else attn_fast_x2(m1, L1, oa0, oa1, m2, L2, ob0, ob1, qf1, qf2, Ks, Vt, 32 * sub, k0, qpos, nm, r, h);
                }
                if (__any((L1[0] > 1e30f) | (L2[0] > 1e30f))) {
                    m1 += 100.f; m2 += 100.f; const float dn = 7.888609052210118e-31f;
#pragma unroll
                    for (int i = 0; i < 16; ++i) { oa0[i] *= dn; oa1[i] *= dn; ob0[i] *= dn; ob1[i] *= dn; L1[i] *= dn; L2[i] *= dn; }
                }
                TL_NEXT(Kg, ZLD, Vg, ZLD, t, ntile, bi);
            }
            l1 = L1[0]; l2 = L2[0];
            const float i1 = 1.f / l1, i2 = lam / l2;
            float ss = 0.f;
#pragma unroll
            for (int i = 0; i < 16; ++i) { oa0[i] = oa0[i] * i1 - ob0[i] * i2; oa1[i] = oa1[i] * i1 - ob1[i] * i2; ss += oa0[i] * oa0[i] + oa1[i] * oa1[i]; }
            ss += __shfl_xor(ss, 32);
            const float rn = rsqrtf(ss * (1.f / 64.f) + EPSN) * (1.f - lam_init);
            bf16_t* orow = Mixed + row * DM + 256 + hd * 64;
#pragma unroll
            for (int g4 = 0; g4 < 4; ++g4) {
                const int dv = 8 * g4 + 4 * h; const f32x4 ga = *(const f32x4*)(gain + hd * 64 + dv), gb = *(const f32x4*)(gain + hd * 64 + 32 + dv);
                u32x2 wa, wb;
                wa.x = pk2(oa0[4 * g4 + 0] * rn * ga.x, oa0[4 * g4 + 1] * rn * ga.y); wa.y = pk2(oa0[4 * g4 + 2] * rn * ga.z, oa0[4 * g4 + 3] * rn * ga.w);
                wb.x = pk2(oa1[4 * g4 + 0] * rn * gb.x, oa1[4 * g4 + 1] * rn * gb.y); wb.y = pk2(oa1[4 * g4 + 2] * rn * gb.z, oa1[4 * g4 + 3] * rn * gb.w);
                *(u32x2*)(orow + dv) = wa; *(u32x2*)(orow + 32 + dv) = wb;
            }
        }
    }
}

__device__ __forceinline__ void phase_win(const Params& p, LAS unsigned char* lds, const bf16_t* Z, const float* G, bf16_t* ACCW, int tid, int wid, int lane) {
    LAS bf16_t* Ks0 = (LAS bf16_t*)lds;
    const int r = lane & 31, h = lane >> 5, hh = wid & 3, qs = wid >> 2;
    const float c = 0.125f * LOG2E;
    TL_DECL
    for (int item = p.bid; item < 1024; item += p.gdim) {
        const int bg = item >> 8, qb = item & 255, b = bg >> 1, g = bg & 1, head = g * 4 + hh;
        const bf16_t* Kg = Z + (size_t)b * SEQ * ZLD + C_KW + g * 64;
        const bf16_t* Vg = Z + (size_t)b * SEQ * ZLD + C_VW + g * 64;
        const int q0w = qb * 64 + 32 * qs, qpos = q0w + r; const size_t row = (size_t)b * SEQ + qpos;
        bf16x8 qf[4];
#pragma unroll
        for (int ks = 0; ks < 4; ++ks) qf[ks] = scale_frag(*(const bf16x8*)(Z + row * ZLD + C_NSQ + head * 64 + 16 * ks + 8 * h), c);
        float m = NEG, l = 0.f; f32x16 o0, o1;
#pragma unroll
        for (int i = 0; i < 16; ++i) { o0[i] = 0.f; o1[i] = 0.f; }
        const int tlo = qb >= 8 ? qb - 8 : 0;
        TL_BEGIN(Kg, ZLD, Vg, ZLD, tlo, qb + 1);
        for (int t = tlo, bi = 0; t <= qb; ++t, bi ^= 1) {
            const LAS bf16_t* Ks = Ks0 + bi * TLB; const LAS bf16_t* Vt = Ks + 64 * KP;
#pragma unroll
            for (int sub = 0; sub < 2; ++sub) {
                const int k0 = 64 * t + 32 * sub;
                if (k0 > q0w + 31 || k0 + 31 <= q0w - 512) continue;
                const bool nm = !((k0 + 31 <= q0w) && (k0 > q0w + 31 - 512));
                attn_sub<4, 1>(m, l, o0, o1, qf, Ks, Vt, 32 * sub, 0, k0, qpos, 1.0f, nm, r, h);
            }
            TL_NEXT(Kg, ZLD, Vg, ZLD, t, qb + 1, bi);
        }
        l += __shfl_xor(l, 32);
        const float gate = sigmoidf_(G[row * 32 + 8 + head * 3 + 2]);
        const float sc = (m > -1e29f) ? gate / l : 0.f;
        bf16_t* arow = ACCW + row * 512 + head * 64;
#pragma unroll
        for (int g4 = 0; g4 < 4; ++g4) { const int dv = 8 * g4 + 4 * h;
            u32x2 a, bq; a.x = pk2(o0[4 * g4] * sc, o0[4 * g4 + 1] * sc); a.y = pk2(o0[4 * g4 + 2] * sc, o0[4 * g4 + 3] * sc);
            bq.x = pk2(o1[4 * g4] * sc, o1[4 * g4 + 1] * sc); bq.y = pk2(o1[4 * g4 + 2] * sc, o1[4 * g4 + 3] * sc);
            *(u32x2*)(arow + dv) = a; *(u32x2*)(arow + 32 + dv) = bq; }
    }
}

__device__ __forceinline__ float gelu_tanh(float x) { const float u = 0.7978845608028654f * (x + 0.044715f * x * x * x); const float e = __expf(2.f * u); const float th = 1.f - 2.f / (e + 1.f); return 0.5f * x * (1.f + th); }
__device__ __forceinline__ void phase_compress(const Params& p, int layer, LAS unsigned char* lds, const bf16_t* Z, bf16_t* KC, int tid, int wid, int lane) {
    LAS bf16_t* As = (LAS bf16_t*)lds;
    LAS bf16_t* Hs = As + 32 * 72;
    const int r = lane & 31, h = lane >> 5;
    const float* CB = (const float*)(p.ws + WS_CB);
    for (int item = p.bid; item < 256; item += p.gdim) {
        const int kv = item >> 7, bg = (item >> 5) & 3, rt = item & 31, c0 = rt * 32, b = bg >> 1, g = bg & 1;
        const bf16_t* src = Z + (size_t)b * SEQ * ZLD + (kv ? C_VC : C_KC) + g * 64;
        const bf16_t* W1 = (const bf16_t*)(p.ws + WS_WC1) + (size_t)(layer * 2 + kv) * 256 * 2048;
        const bf16_t* W2 = (const bf16_t*)(p.ws + WS_WC2) + (size_t)(layer * 2 + kv) * 64 * 256;
        const int n = wid * 32 + r;
        f32x16 acc;
#pragma unroll
        for (int i = 0; i < 16; ++i) acc[i] = 0.f;
        for (int tok = 0; tok < 32; ++tok) {
            bf16x8 bf[4];
#pragma unroll
            for (int ks = 0; ks < 4; ++ks) bf[ks] = *(const bf16x8*)(W1 + (size_t)n * 2048 + tok * 64 + 16 * ks + 8 * h);
            u32x4 av = {0u, 0u, 0u, 0u};
            if (tid < 256) { int token = 16 * (c0 + (tid >> 3)) + tok; token = token < SEQ ? token : SEQ - 1; av = *(const u32x4*)(src + (size_t)token * ZLD + (tid & 7) * 8); }
            __syncthreads();
#if DBG_SCRUBZ
            { unsigned w[4] = {av.x, av.y, av.z, av.w};
              for (int e = 0; e < 4; ++e) { if (((w[e] >> 7) & 0xffu) > 140u) w[e] &= 0xffff0000u; if (((w[e] >> 23) & 0xffu) > 140u) w[e] &= 0x0000ffffu; }
              av.x = w[0]; av.y = w[1]; av.z = w[2]; av.w = w[3]; }
#endif
            if (tid < 256) *(LAS u32x4*)(As + (tid >> 3) * 72 + (tid & 7) * 8) = av;
            __syncthreads();
#pragma unroll
            for (int ks = 0; ks < 4; ++ks) { const bf16x8 a = *(const LAS bf16x8*)(As + r * 72 + 16 * ks + 8 * h); acc = __builtin_amdgcn_mfma_f32_32x32x16_bf16(a, bf[ks], acc, 0, 0, 0); }
        }
        const float bias = CB[(layer * 2 + kv) * 256 + n];
#pragma unroll
        for (int i = 0; i < 16; ++i) Hs[rowi32(i, h) * 264 + n] = f2bf(gelu_tanh(acc[i] + bias));
        __syncthreads();
        if (wid < 2) {
            f32x16 o;
#pragma unroll
            for (int i = 0; i < 16; ++i) o[i] = 0.f;
            const int n2 = wid * 32 + r;
#pragma unroll
            for (int ks = 0; ks < 16; ++ks) { const bf16x8 a = *(const LAS bf16x8*)(Hs + r * 264 + 16 * ks + 8 * h); const bf16x8 bw = *(const bf16x8*)(W2 + (size_t)n2 * 256 + 16 * ks + 8 * h);
                o = __builtin_amdgcn_mfma_f32_32x32x16_bf16(a, bw, o, 0, 0, 0); }
#pragma unroll
            for (int i = 0; i < 16; ++i) { float v = o[i];
#if DBG_SCRUBKC
                if (!(fabsf(v) < 1e4f)) v = 0.f;
#endif
                KC[((size_t)(kv * 4 + bg) * 1024 + c0 + rowi32(i, h)) * 64 + n2] = f2bf(v); }
        }
        __syncthreads();
    }
}

typedef unsigned long long u64_t;
__device__ __forceinline__ unsigned pk4_fp8(float a, float b, float c, float d) { int w = __builtin_amdgcn_cvt_pk_fp8_f32(a, b, 0, false); w = __builtin_amdgcn_cvt_pk_fp8_f32(c, d, w, true); return (unsigned)w; }
__device__ __forceinline__ u32x2 bf8_to_fp8(u32x4 v) {
    u32x2 o;
    o.x = pk4_fp8(__uint_as_float(v.x << 16), __uint_as_float(v.x & 0xffff0000u), __uint_as_float(v.y << 16), __uint_as_float(v.y & 0xffff0000u));
    o.y = pk4_fp8(__uint_as_float(v.z << 16), __uint_as_float(v.z & 0xffff0000u), __uint_as_float(v.w << 16), __uint_as_float(v.w & 0xffff0000u));
    return o;
}
__device__ __forceinline__ void phase_vst(const Params& p, LAS unsigned char* lds, const bf16_t* Z, unsigned char* K8, unsigned char* V8T, int tid) {
    LAS bf16_t* Vt = (LAS bf16_t*)lds;
    const int vkey = tid & 63, vch = tid >> 6;
    for (int item = p.bid; item < 1024; item += p.gdim) {
        const int bg = item >> 8, tt = item & 255, b = bg >> 1, g = bg & 1;
        const u32x4 v = *(const u32x4*)(Z + ((size_t)b * SEQ + 64 * tt + vkey) * ZLD + C_VS + g * 64 + vch * 8);
        { const int key = tid >> 3, ch = tid & 7;
          const u32x4 kk = *(const u32x4*)(Z + ((size_t)b * SEQ + 64 * tt + key) * ZLD + C_KS + g * 64 + ch * 8);
          *(u32x2*)(K8 + ((size_t)bg * SEQ + 64 * tt + key) * 64 + (ch & 3) * 16 + (ch >> 2) * 8) = bf8_to_fp8(kk); }
        __syncthreads();
        Vt[(vch * 8 + 0) * VP + vkey] = (bf16_t)(v.x & 0xffffu); Vt[(vch * 8 + 1) * VP + vkey] = (bf16_t)(v.x >> 16);
        Vt[(vch * 8 + 2) * VP + vkey] = (bf16_t)(v.y & 0xffffu); Vt[(vch * 8 + 3) * VP + vkey] = (bf16_t)(v.y >> 16);
        Vt[(vch * 8 + 4) * VP + vkey] = (bf16_t)(v.z & 0xffffu); Vt[(vch * 8 + 5) * VP + vkey] = (bf16_t)(v.z >> 16);
        Vt[(vch * 8 + 6) * VP + vkey] = (bf16_t)(v.w & 0xffffu); Vt[(vch * 8 + 7) * VP + vkey] = (bf16_t)(v.w >> 16);
        __syncthreads();
        const int dv = tid >> 3, ch = tid & 7;
        *(u32x2*)(V8T + (((size_t)bg * 256 + tt) * 64 + dv) * 64 + (ch & 3) * 16 + (ch >> 2) * 8) = bf8_to_fp8(*(const LAS u32x4*)(Vt + dv * VP + ch * 8));
    }
}

__device__ __forceinline__ void ml_scan_line(float* __restrict__ pc, size_t stride, const float* __restrict__ GA, float* __restrict__ MP, int bh, bool write_m);
__device__ __forceinline__ void phase_cmp(const Params& p, LAS unsigned char* lds, const bf16_t* Z, const float* G, const bf16_t* KC, const bf16_t* ACCW, float* ACC, int* IDX,
                                          float* CL, float* NL, const float* GA, float* MP, unsigned* ctr, int tid, int wid, int lane) {
    LAS int* qsh = (LAS int*)(lds + 106496);
    LAS bf16_t* Ks0 = (LAS bf16_t*)lds;
    LAS unsigned* PS = (LAS unsigned*)(lds + 40960);
    const int r = lane & 31, h = lane >> 5, hh = wid & 3, qs = wid >> 2;
    const float c = 0.125f * LOG2E;
    TL_DECL
    for (;;) {
        __syncthreads();
        if (tid == 0) qsh[0] = (int)__hip_atomic_fetch_add(ctr, 1u, __ATOMIC_RELAXED, __HIP_MEMORY_SCOPE_AGENT);
        __syncthreads();
        const int qit = qsh[0];
        if (qit >= 65 + 1024) break;
        if (qit < 65) {
            if (qit < 64) { const int gid = qit * 512 + tid, bh = gid >> 12, e = gid & 4095; ml_scan_line(CL + (size_t)bh * 256 * 4096 + e, 4096, GA, MP, bh, e == 0); }
            else { const int bh = tid >> 6, k = tid & 63; ml_scan_line(NL + (size_t)bh * 256 * 64 + k, 64, GA, MP, bh, false); }
            continue;
        }
        const int bg = (qit - 65) & 3, qb = 255 - ((qit - 65) >> 2), b = bg >> 1, g = bg & 1, head = g * 4 + hh;
        const bf16_t* Kg = KC + (size_t)(0 * 4 + bg) * 1024 * 64;
        const bf16_t* Vg = KC + (size_t)(1 * 4 + bg) * 1024 * 64;
        const int q0w = qb * 64 + 32 * qs, qpos = q0w + r, ql = 32 * qs + r; const size_t row = (size_t)b * SEQ + qpos;
        bf16x8 qf[4];
#pragma unroll
        for (int ks = 0; ks < 4; ++ks) qf[ks] = scale_frag(*(const bf16x8*)(Z + row * ZLD + C_NSQ + head * 64 + 16 * ks + 8 * h), c);
        float m = NEG, l = 0.f; f32x16 o0, o1;
#pragma unroll
        for (int i = 0; i < 16; ++i) { o0[i] = 0.f; o1[i] = 0.f; }
        const int ncb = 4 * qb + 3, nt = (ncb + 63) >> 6;
        TL_BEGIN(Kg, 64, Vg, 64, 0, nt);
        for (int t = 0, bi = 0; t < nt; ++t, bi ^= 1) {
            const LAS bf16_t* Ks = Ks0 + bi * TLB; const LAS bf16_t* Vt = Ks + 64 * KP;
#pragma unroll
            for (int sub = 0; sub < 2; ++sub) {
                const int k0 = 64 * t + 32 * sub;
                if (16 * k0 + 31 > q0w + 31) continue;
                const bool nm = (16 * (k0 + 31) + 31 > q0w);
                attn_sub<4, 2>(m, l, o0, o1, qf, Ks, Vt, 32 * sub, 0, k0, qpos, 1.0f, nm, r, h);
            }
            TL_NEXT(Kg, 64, Vg, 64, t, nt, bi);
        }
        l += __shfl_xor(l, 32);
        const bool valid = m > -1e29f;
        const float invL = valid ? 1.f / l : 0.f;
        if (!DBG_NOCMPACC) {
            const float sc = sigmoidf_(G[row * 32 + 8 + head * 3 + 0]) * invL;
            float* arow = ACC + row * 512 + head * 64; const bf16_t* wrow = ACCW + row * 512 + head * 64;
#pragma unroll
            for (int g4 = 0; g4 < 4; ++g4) { const int dv = 8 * g4 + 4 * h;
                const u32x2 wa = *(const u32x2*)(wrow + dv), wb = *(const u32x2*)(wrow + 32 + dv);
                f32x4 a = {__uint_as_float(wa.x << 16), __uint_as_float(wa.x & 0xffff0000u), __uint_as_float(wa.y << 16), __uint_as_float(wa.y & 0xffff0000u)};
                f32x4 bq = {__uint_as_float(wb.x << 16), __uint_as_float(wb.x & 0xffff0000u), __uint_as_float(wb.y << 16), __uint_as_float(wb.y & 0xffff0000u)};
                a.x += o0[4 * g4] * sc; a.y += o0[4 * g4 + 1] * sc; a.z += o0[4 * g4 + 2] * sc; a.w += o0[4 * g4 + 3] * sc;
                bq.x += o1[4 * g4] * sc; bq.y += o1[4 * g4 + 1] * sc; bq.z += o1[4 * g4 + 2] * sc; bq.w += o1[4 * g4 + 3] * sc;
#if DBG_SCRUB
                for (int e = 0; e < 4; ++e) { if (!(fabsf(a[e]) < 1e20f)) a[e] = 0.f; if (!(fabsf(bq[e]) < 1e20f)) bq[e] = 0.f; }
#endif
                *(f32x4*)(arow + dv) = a; *(f32x4*)(arow + 32 + dv) = bq; }
        }
        if (qb >= 16) {
            __syncthreads();
            for (int e = tid; e < 16384; e += 512) PS[e] = 0u;
            TL_BEGIN(Kg, 64, Vg, 64, 0, nt);
            for (int t = 0, bi = 0; t < nt; ++t, bi ^= 1) {
                const LAS bf16_t* Ks = Ks0 + bi * TLB;
#pragma unroll
                for (int sub = 0; sub < 2; ++sub) {
                    const int k0 = 64 * t + 32 * sub;
                    if (16 * k0 + 31 > q0w + 31) continue;
                    f32x16 s = qk_sub<4>(qf, Ks, 32 * sub, 0, r, h);
#pragma unroll
                    for (int g4 = 0; g4 < 4; ++g4) {
                        float sum4 = 0.f, p3 = 0.f;
#pragma unroll
                        for (int e = 0; e < 4; ++e) { const int key = k0 + 8 * g4 + 4 * h + e; const float pv = (16 * key + 31 <= qpos) ? ex2(s[4 * g4 + e] - m) * invL : 0.f; sum4 += pv; if (e == 3) p3 = pv; }
                        const int j = (k0 >> 2) + 2 * g4 + h;
                        __hip_atomic_fetch_add((unsigned*)(PS + j * 64 + ql), (unsigned)(sum4 * 268435456.f + 0.5f), __ATOMIC_RELAXED, __HIP_MEMORY_SCOPE_WORKGROUP);
                        if (j + 1 < 256) __hip_atomic_fetch_add((unsigned*)(PS + (j + 1) * 64 + ql), (unsigned)(p3 * 268435456.f + 0.5f), __ATOMIC_RELAXED, __HIP_MEMORY_SCOPE_WORKGROUP);
                    }
                }
                TL_NEXT(Kg, 64, Vg, 64, t, nt, bi);
            }
            __syncthreads();
            for (int qi = wid; qi < 64; qi += 8) {
                const int cur = qb;
                unsigned v[4]; bool ok[4];
#pragma unroll
                for (int i = 0; i < 4; ++i) { const int j = lane + 64 * i; ok[i] = (j >= 1) && (j <= cur - 2); v[i] = ok[i] ? PS[j * 64 + qi] : 0u; }
                unsigned T = 0u;
                for (int bit = 30; bit >= 0; --bit) { const unsigned trial = T | (1u << bit); int cnt = 0;
#pragma unroll
                    for (int i = 0; i < 4; ++i) cnt += __builtin_popcountll(__ballot(ok[i] && v[i] >= trial));
                    if (cnt >= 13) T = trial; }
                int n_gt = 0;
#pragma unroll
                for (int i = 0; i < 4; ++i) n_gt += __builtin_popcountll(__ballot(ok[i] && v[i] > T));
                int* dst = IDX + (((size_t)b * SEQ + qb * 64 + qi) * 2 + g) * 16;
                if (lane == 0) { dst[0] = 0; dst[1] = cur - 1; dst[2] = cur; }
                int pos_gt = 3, eq_seen = 0; const int eq_base = 3 + n_gt, need = 13 - n_gt;
#pragma unroll
                for (int i = 0; i < 4; ++i) {
                    const bool gt = ok[i] && v[i] > T, eq = ok[i] && v[i] == T;
                    const unsigned long long mg = __ballot(gt), me = __ballot(eq);
                    const int rg = __builtin_amdgcn_mbcnt_hi((unsigned)(mg >> 32), __builtin_amdgcn_mbcnt_lo((unsigned)mg, 0u));
                    const int re = __builtin_amdgcn_mbcnt_hi((unsigned)(me >> 32), __builtin_amdgcn_mbcnt_lo((unsigned)me, 0u));
                    if (gt) dst[pos_gt + rg] = lane + 64 * i;
                    if (eq && eq_seen + re < need) dst[eq_base + eq_seen + re] = lane + 64 * i;
                    pos_gt += __builtin_popcountll(mg); eq_seen += __builtin_popcountll(me);
                }
            }
        } else {
            for (int e = tid; e < 1024; e += 512) { const int qi = e >> 4, k = e & 15; IDX[(((size_t)b * SEQ + qb * 64 + qi) * 2 + g) * 16 + k] = (k <= qb) ? k : -1; }
        }
    }
}

typedef long l64x2 __attribute__((ext_vector_type(2)));
struct SelBuf { l64x2 k[4]; l64x2 v[4]; };
__device__ __forceinline__ void sel_load(SelBuf& B, const unsigned char* Kb, const unsigned char* Vb, int jb, int cc, int q4) {
#pragma unroll
    for (int ht = 0; ht < 4; ++ht) { const int keyrow = jb * 64 + 32 * (ht >> 1) + 8 * (cc >> 2) + (cc & 3) + 4 * (ht & 1);
        B.k[ht] = *(const l64x2*)(Kb + (size_t)keyrow * 64 + q4 * 16); }
#pragma unroll
    for (int d = 0; d < 4; ++d) B.v[d] = *(const l64x2*)(Vb + ((size_t)jb * 64 + 16 * d + cc) * 64 + q4 * 16);
}
__device__ __forceinline__ void sel_load_any(SelBuf& B, const unsigned char* Kb, const unsigned char* Vb, const LAS unsigned char* fl, int jb, int cur, int cc, int q4) {
    const int slot = (jb == 0) ? 0 : ((jb == cur - 1) ? 1 : ((jb == cur) ? 2 : -1));
    if (slot < 0) { sel_load(B, Kb, Vb, jb, cc, q4); return; }
    const LAS unsigned char* fk = fl + slot * 8192; const LAS unsigned char* fv = fk + 4096;
#pragma unroll
    for (int ht = 0; ht < 4; ++ht) { const int keyrow = 32 * (ht >> 1) + 8 * (cc >> 2) + (cc & 3) + 4 * (ht & 1); B.k[ht] = *(const LAS l64x2*)(fk + keyrow * 64 + q4 * 16); }
#pragma unroll
    for (int d = 0; d < 4; ++d) B.v[d] = *(const LAS l64x2*)(fv + (16 * d + cc) * 64 + q4 * 16);
}
__device__ __forceinline__ long mk64(unsigned lo, unsigned hi) { const u32x2 v = {lo, hi}; return __builtin_bit_cast(long, v); }
__device__ __forceinline__ void sel_compute2(float& m, float& l, f32x4 (&o)[4], const long (&qf)[2], const SelBuf& A, const SelBuf& B, int kbA, int kbB, bool diagA, bool diagB, bool validB, int t, float c, int q4) {
    f32x4 s[8];
#pragma unroll
    for (int ht = 0; ht < 4; ++ht) { f32x4 a = {0.f, 0.f, 0.f, 0.f}, bq = {0.f, 0.f, 0.f, 0.f};
        a = __builtin_amdgcn_mfma_f32_16x16x32_fp8_fp8(A.k[ht].x, qf[0], a, 0, 0, 0);
        bq = __builtin_amdgcn_mfma_f32_16x16x32_fp8_fp8(B.k[ht].x, qf[0], bq, 0, 0, 0);
        a = __builtin_amdgcn_mfma_f32_16x16x32_fp8_fp8(A.k[ht].y, qf[1], a, 0, 0, 0);
        bq = __builtin_amdgcn_mfma_f32_16x16x32_fp8_fp8(B.k[ht].y, qf[1], bq, 0, 0, 0);
        s[ht] = a; s[4 + ht] = bq; }
    if (diagA | diagB | !validB) {
#pragma unroll
        for (int ht = 0; ht < 4; ++ht)
#pragma unroll
            for (int e = 0; e < 4; ++e) { const int ko = 32 * (ht >> 1) + 8 * q4 + 4 * (ht & 1) + e;
                if (diagA && kbA + ko > t) s[ht][e] = NEG;
                if (!validB || (diagB && kbB + ko > t)) s[4 + ht][e] = NEG; }
    }
    float mt = s[0][0];
#pragma unroll
    for (int ht = 0; ht < 8; ++ht)
#pragma unroll
        for (int e = 0; e < 4; ++e) mt = fmaxf(mt, s[ht][e]);
    mt = fmaxf(mt, __shfl_xor(mt, 16)); mt = fmaxf(mt, __shfl_xor(mt, 32));
    const float mn = fmaxf(m, mt);
    float alpha = 1.f;
    if (__any(mn != m)) {
        alpha = ex2((m - mn) * c);
#pragma unroll
        for (int d = 0; d < 4; ++d) o[d] = o[d] * alpha;
    }
    m = mn;
    f32x2_t ps2 = {0.f, 0.f}; const f32x2_t c2 = {c, c}, mn2 = {mn, mn}, e8 = {8.f, 8.f};
#pragma unroll
    for (int ht = 0; ht < 8; ++ht)
#pragma unroll
        for (int e = 0; e < 4; e += 2) { f32x2_t tt = {s[ht][e], s[ht][e + 1]}; tt = (tt - mn2) * c2 + e8; s[ht][e] = ex2(tt.x); s[ht][e + 1] = ex2(tt.y); const f32x2_t pp = {s[ht][e], s[ht][e + 1]}; ps2 += pp; }
    l = l * alpha + (ps2.x + ps2.y);
#pragma unroll
    for (int half = 0; half < 2; ++half) {
        const long pa = mk64(pk4_fp8(s[2 * half][0], s[2 * half][1], s[2 * half][2], s[2 * half][3]), pk4_fp8(s[2 * half + 1][0], s[2 * half + 1][1], s[2 * half + 1][2], s[2 * half + 1][3]));
        const long pbb = mk64(pk4_fp8(s[4 + 2 * half][0], s[4 + 2 * half][1], s[4 + 2 * half][2], s[4 + 2 * half][3]), pk4_fp8(s[4 + 2 * half + 1][0], s[4 + 2 * half + 1][1], s[4 + 2 * half + 1][2], s[4 + 2 * half + 1][3]));
#pragma unroll
        for (int d = 0; d < 4; ++d) {
            o[d] = __builtin_amdgcn_mfma_f32_16x16x32_fp8_fp8(half ? A.v[d].y : A.v[d].x, pa, o[d], 0, 0, 0);
            o[d] = __builtin_amdgcn_mfma_f32_16x16x32_fp8_fp8(half ? B.v[d].y : B.v[d].x, pbb, o[d], 0, 0, 0); }
    }
}
__device__ __forceinline__ void phase_sel(const Params& p, LAS unsigned char* lds, const bf16_t* Z, const float* G, const unsigned char* K8, const unsigned char* V8T, const float* ACC, const int* IDX, bf16_t* Mixed, int tid, int wid, int lane) {
    const int cc = lane & 15, q4 = lane >> 4, hh = cc & 3;
    const float c = 0.125f * LOG2E;
    const int gw = p.bid * 8 + wid, NGW = p.gdim * 8;
    int idx_n = -1, bg_staged = -1;
#define SEL_PREFETCH(pi) do { const int bg_ = (pi) >> 14, t_ = (pi) & (SEQ - 1), b_ = bg_ >> 1, g_ = bg_ & 1, cur_ = t_ >> 6; const size_t row_ = (size_t)b_ * SEQ + t_; \
        idx_n = (lane < 16) ? IDX[(row_ * 2 + g_) * 16 + lane] : -1; \
        } while (0)
    if (gw < 4 * SEQ) SEL_PREFETCH(gw);
    for (int pidx = gw; pidx < 4 * SEQ; pidx += NGW) {
        const int bg = pidx >> 14, t = pidx & (SEQ - 1), b = bg >> 1, g = bg & 1, cur = t >> 6;
        const size_t row = (size_t)b * SEQ + t;
        const int myidx = idx_n;
        const u32x4 qr0 = *(const u32x4*)(Z + row * ZLD + C_NSQ + (g * 4 + hh) * 64 + 8 * q4), qr1 = *(const u32x4*)(Z + row * ZLD + C_NSQ + (g * 4 + hh) * 64 + 32 + 8 * q4);
        u32x4 st[2];
#pragma unroll
        for (int i = 0; i < 2; ++i) { const int isv = tid >> 8, off = (tid & 255) * 16; const int fb = i == 0 ? (cur > 0 ? cur - 1 : 0) : cur;
            st[i] = *(const u32x4*)((isv ? V8T : K8) + (size_t)bg * SEQ * 64 + (size_t)fb * 4096 + off); }
        __syncthreads();
#pragma unroll
        for (int i = 0; i < 2; ++i) { const int isv = tid >> 8, off = (tid & 255) * 16; *(LAS u32x4*)(lds + (1 + i) * 8192 + isv * 4096 + off) = st[i]; }
        if (bg != bg_staged) { const int isv = tid >> 8, off = (tid & 255) * 16;
            *(LAS u32x4*)(lds + isv * 4096 + off) = *(const u32x4*)((isv ? V8T : K8) + (size_t)bg * SEQ * 64 + off); bg_staged = bg; }
        __syncthreads();
        if (pidx + NGW < 4 * SEQ) SEL_PREFETCH(pidx + NGW);
        long qf[2];
        { const u32x2 qa = bf8_to_fp8(qr0), qb2 = bf8_to_fp8(qr1); qf[0] = mk64(qa.x, qa.y); qf[1] = mk64(qb2.x, qb2.y); }
        const int nblk = __builtin_popcountll(__ballot(myidx >= 0));
        const int head = g * 4 + (cc & 3);
        const float gate_pre = G[row * 32 + 8 + head * 3 + 1];
        LAS unsigned char* land = lds + 32768 + wid * 4096;
#pragma unroll
        for (int d = 0; d < 4; ++d) __builtin_amdgcn_global_load_lds((const unsigned*)(ACC + row * 512 + head * 64 + 16 * d + 4 * q4), (LAS unsigned*)(land + d * 1024), 16, 0, 0);
        float m = NEG, l = 0.f; f32x4 o[4];
#pragma unroll
        for (int d = 0; d < 4; ++d) o[d] = (f32x4){0.f, 0.f, 0.f, 0.f};
        const unsigned char* Kb = K8 + (size_t)bg * SEQ * 64;
        const unsigned char* Vb = V8T + (size_t)bg * SEQ * 64;
        SelBuf b0, b1, b2, b3;
        const int last = nblk - 1;
#define SEL_IDX(i) __shfl(myidx, (i) < last ? (i) : last)
        int j0 = SEL_IDX(0), j1 = SEL_IDX(1), j2 = SEL_IDX(2), j3 = SEL_IDX(3);
        sel_load_any(b0, Kb, Vb, lds, j0, cur, cc, q4); sel_load_any(b1, Kb, Vb, lds, j1, cur, cc, q4); sel_load_any(b2, Kb, Vb, lds, j2, cur, cc, q4); sel_load_any(b3, Kb, Vb, lds, j3, cur, cc, q4);
        for (int k = 0; k < nblk; k += 4) {
            sel_compute2(m, l, o, qf, b0, b1, j0 * 64, j1 * 64, j0 == cur, j1 == cur, k + 1 < nblk, t, c, q4);
            if (k + 4 < nblk) { j0 = SEL_IDX(k + 4); j1 = SEL_IDX(k + 5); sel_load_any(b0, Kb, Vb, lds, j0, cur, cc, q4); sel_load_any(b1, Kb, Vb, lds, j1, cur, cc, q4); }
            if (k + 2 < nblk) sel_compute2(m, l, o, qf, b2, b3, j2 * 64, j3 * 64, j2 == cur, j3 == cur, k + 3 < nblk, t, c, q4);
            if (k + 6 < nblk) { j2 = SEL_IDX(k + 6); j3 = SEL_IDX(k + 7); sel_load_any(b2, Kb, Vb, lds, j2, cur, cc, q4); sel_load_any(b3, Kb, Vb, lds, j3, cur, cc, q4); }
        }
#undef SEL_IDX
        l += __shfl_xor(l, 16); l += __shfl_xor(l, 32);
        asm volatile("s_waitcnt vmcnt(0)" ::: "memory");
        if (cc < 4) {
            const float sc = (m > -1e29f) ? sigmoidf_(gate_pre) / l : 0.f;
#pragma unroll
            for (int d = 0; d < 4; ++d) { const int dv = 16 * d + 4 * q4; const f32x4 a = *(const LAS f32x4*)(land + d * 1024 + lane * 16);
                u32x2 w; w.x = pk2(a.x + o[d][0] * sc, a.y + o[d][1] * sc); w.y = pk2(a.z + o[d][2] * sc, a.w + o[d][3] * sc);
                *(u32x2*)(Mixed + row * DM + 512 + head * 64 + dv) = w; }
        }
    }
#undef SEL_PREFETCH
}

__device__ __forceinline__ float ml_conv_silu(const bf16_t* Z, const float* conv, int b, int t, int zcol, int ch) {
    float a = 0.f;
#pragma unroll
    for (int j = 0; j < 4; ++j) { const int tt = t - 3 + j; if (tt >= 0) a += conv[j * 512 + ch] * bf2f(Z[((size_t)b * SEQ + tt) * ZLD + zcol]); }
    return a * sigmoidf_(a);
}
__device__ __forceinline__ void conv8_silu(const u32x4 (&zr)[4], const float* conv, int ch0, float scale, float (&o)[8]) {
    float acc[8];
#pragma unroll
    for (int i = 0; i < 8; ++i) acc[i] = 0.f;
#pragma unroll
    for (int j = 0; j < 4; ++j) { float z[8]; unpack8(zr[j], z); const f32x4 w0 = *(const f32x4*)(conv + j * 512 + ch0), w1 = *(const f32x4*)(conv + j * 512 + ch0 + 4);
#pragma unroll
        for (int i = 0; i < 4; ++i) { acc[i] += w0[i] * z[i]; acc[4 + i] += w1[i] * z[4 + i]; } }
#pragma unroll
    for (int i = 0; i < 8; ++i) o[i] = acc[i] * sigmoidf_(acc[i]) * scale;
}
__device__ __forceinline__ void load_taps(const bf16_t* Z, int b, int t, int zcol0, u32x4 (&zr)[4]) {
#pragma unroll
    for (int j = 0; j < 4; ++j) { const int tt = t - 3 + j; zr[j] = (tt >= 0) ? *(const u32x4*)(Z + ((size_t)b * SEQ + tt) * ZLD + zcol0) : (u32x4){0u, 0u, 0u, 0u}; }
}
constexpr int MLP = 72;
__device__ __forceinline__ void phase_ml_local(const Params& p, int layer, LAS unsigned char* lds, const bf16_t* Z, const float* G, float* CL, float* NL, float* GA, int tid, int wid, int lane) {
    LAS bf16_t* KsT = (LAS bf16_t*)lds;
    LAS bf16_t* VtW = KsT + 64 * MLP;
    LAS float* wl = (LAS float*)(VtW + 64 * MLP);
    const float* conv = p.ml_conv + layer * 4 * 512; const float* bias = p.ml_gate_bias + layer * 8;
    const int li = tid >> 3, d0 = (tid & 7) * 8, r = lane & 31, h = lane >> 5;
    for (int item = p.bid; item < 2048; item += p.gdim) {
        const int bh = item >> 8, ck = item & 255, b = bh >> 2, hd = bh & 3, t0 = ck * 64, t = t0 + li;
        u32x4 zk[4]; load_taps(Z, b, t, C_MLK + hd * 64 + d0, zk);
        const u32x4 zv = *(const u32x4*)(Z + ((size_t)b * SEQ + t) * ZLD + C_MLV + hd * 64 + d0);
        __syncthreads();
        if (wid == 0) {
            const size_t row = (size_t)b * SEQ + t0 + lane;
            const float ig = G[row * 32 + hd] + bias[hd], lf = log_sigmoid(G[row * 32 + 4 + hd] + bias[4 + hd]);
            const float bs = wave_incl_scan(lf, lane), gsum = __shfl(bs, 63), a = gsum - bs + ig, amax = wave_max(a);
            wl[lane] = __expf(a - amax);
            if (lane == 0) { GA[(bh * 256 + ck) * 2] = gsum; GA[(bh * 256 + ck) * 2 + 1] = amax; }
        }
        __syncthreads();
        { float k8[8], v8[8]; conv8_silu(zk, conv, 256 + hd * 64 + d0, 0.125f, k8); unpack8(zv, v8); const float w = wl[li];
#pragma unroll
          for (int i = 0; i < 8; ++i) { KsT[(d0 + i) * MLP + li] = f2bf(k8[i]); VtW[(d0 + i) * MLP + li] = f2bf(v8[i] * w); } }
        __syncthreads();
        if (wid < 4) {
            const int vi = wid >> 1, ki = wid & 1;
            f32x16 acc;
#pragma unroll
            for (int i = 0; i < 16; ++i) acc[i] = 0.f;
#pragma unroll
            for (int ks = 0; ks < 4; ++ks) { const bf16x8 av = *(const LAS bf16x8*)(VtW + (32 * vi + r) * MLP + 16 * ks + 8 * h), bk = *(const LAS bf16x8*)(KsT + (32 * ki + r) * MLP + 16 * ks + 8 * h);
                acc = __builtin_amdgcn_mfma_f32_32x32x16_bf16(av, bk, acc, 0, 0, 0); }
            float* dst = CL + (size_t)(bh * 256 + ck) * 4096 + 32 * ki + r;
#pragma unroll
            for (int i = 0; i < 16; ++i) dst[(32 * vi + rowi32(i, h)) * 64] = acc[i];
        } else if (wid == 4) {
            float n = 0.f;
            for (int l8 = 0; l8 < 64; l8 += 8) { float kk[8]; unpack8(*(const LAS u32x4*)(KsT + lane * MLP + l8), kk);
#pragma unroll
                for (int i = 0; i < 8; ++i) n += wl[l8 + i] * kk[i]; }
            NL[(size_t)(bh * 256 + ck) * 64 + lane] = n;
        }
    }
}
__device__ __forceinline__ void ml_scan_line(float* __restrict__ pc, size_t stride, const float* __restrict__ GA, float* __restrict__ MP, int bh, bool write_m) {
    float C = 0.f, m = 0.f;
    for (int c0 = 0; c0 < 256; c0 += 8) {
        float tmp[8], gs[8], am[8];
#pragma unroll
        for (int u = 0; u < 8; ++u) { tmp[u] = pc[(size_t)(c0 + u) * stride]; const float2 ga = *(const float2*)(GA + (bh * 256 + c0 + u) * 2); gs[u] = ga.x; am[u] = ga.y; }
#pragma unroll
        for (int u = 0; u < 8; ++u) { const int ck = c0 + u;
            const float mn = fmaxf(gs[u] + m, am[u]), sp = __expf(gs[u] + m - mn), sl = __expf(am[u] - mn);
            pc[(size_t)ck * stride] = C; if (write_m) MP[bh * 256 + ck] = m;
            C = sp * C + sl * tmp[u]; m = mn; }
    }
}
__device__ __forceinline__ void phase_ml_scan(const Params& p, float* CL, float* NL, const float* GA, float* MP, int wid, int lane) {
    if (wid < 2) {
        for (int gid = p.bid * 128 + wid * 64 + lane; gid < 32768; gid += p.gdim * 128) { const int bh = gid >> 12, e = gid & 4095;
            ml_scan_line(CL + (size_t)bh * 256 * 4096 + e, 4096, GA, MP, bh, e == 0); }
    } else if (wid == 2) {
        for (int gid = p.bid * 64 + lane; gid < 512; gid += p.gdim * 64) { const int bh = gid >> 6, k = gid & 63;
            ml_scan_line(NL + (size_t)bh * 256 * 64 + k, 64, GA, MP, bh, false); }
    }
}
__device__ __forceinline__ void phase_ml_out(const Params& p, int layer, LAS unsigned char* lds, const bf16_t* Z, const float* G, const float* CL, const float* NL, const float* MP, bf16_t* Mixed, int tid, int wid, int lane) {
    LAS bf16_t* Qs = (LAS bf16_t*)lds;
    LAS bf16_t* Ks = Qs + 64 * MLP;
    LAS bf16_t* Vt = Ks + 64 * MLP;
    LAS bf16_t* Cs = Vt + 64 * MLP;
    LAS bf16_t* Ql = Cs + 64 * MLP;
    LAS bf16_t* Kl = Ql + 64 * MLP;
    LAS float* bL = (LAS float*)(Kl + 64 * MLP); LAS float* uL = bL + 64; LAS float* mtL = uL + 64; LAS float* siL = mtL + 64; LAS float* npL = siL + 64;
    const float* conv = p.ml_conv + layer * 4 * 512; const float* bias = p.ml_gate_bias + layer * 8; const float* gain = p.ml_norm + layer * 256;
    const int li = tid >> 3, d0 = (tid & 7) * 8, r = lane & 31, h = lane >> 5;
    for (int item = p.bid; item < 2048; item += p.gdim) {
        const int bh = item >> 8, ck = item & 255, b = bh >> 2, hd = bh & 3, t0 = ck * 64;
        {
            const int t = t0 + li;
            u32x4 zq[4], zk[4]; load_taps(Z, b, t, C_MLQ + hd * 64 + d0, zq); load_taps(Z, b, t, C_MLK + hd * 64 + d0, zk);
            const u32x4 zv = *(const u32x4*)(Z + ((size_t)b * SEQ + t) * ZLD + C_MLV + hd * 64 + d0);
            const float* cp = CL + (size_t)(bh * 256 + ck) * 4096 + li * 64 + d0;
            const f32x4 c0 = *(const f32x4*)cp, c1 = *(const f32x4*)(cp + 4);
            float q8[8], k8[8]; conv8_silu(zq, conv, hd * 64 + d0, 1.f, q8); conv8_silu(zk, conv, 256 + hd * 64 + d0, 0.125f, k8);
            __syncthreads();
            u32x4 w; w.x = pk2(q8[0], q8[1]); w.y = pk2(q8[2], q8[3]); w.z = pk2(q8[4], q8[5]); w.w = pk2(q8[6], q8[7]); *(LAS u32x4*)(Qs + li * MLP + d0) = w;
            { float hi[8]; unpack8(w, hi); u32x4 wl2; wl2.x = pk2(q8[0] - hi[0], q8[1] - hi[1]); wl2.y = pk2(q8[2] - hi[2], q8[3] - hi[3]); wl2.z = pk2(q8[4] - hi[4], q8[5] - hi[5]); wl2.w = pk2(q8[6] - hi[6], q8[7] - hi[7]); *(LAS u32x4*)(Ql + li * MLP + d0) = wl2; }
            w.x = pk2(k8[0], k8[1]); w.y = pk2(k8[2], k8[3]); w.z = pk2(k8[4], k8[5]); w.w = pk2(k8[6], k8[7]); *(LAS u32x4*)(Ks + li * MLP + d0) = w;
            { float hi[8]; unpack8(w, hi); u32x4 wl2; wl2.x = pk2(k8[0] - hi[0], k8[1] - hi[1]); wl2.y = pk2(k8[2] - hi[2], k8[3] - hi[3]); wl2.z = pk2(k8[4] - hi[4], k8[5] - hi[5]); wl2.w = pk2(k8[6] - hi[6], k8[7] - hi[7]); *(LAS u32x4*)(Kl + li * MLP + d0) = wl2; }
            w.x = pk2(c0[0], c0[1]); w.y = pk2(c0[2], c0[3]); w.z = pk2(c1[0], c1[1]); w.w = pk2(c1[2], c1[3]); *(LAS u32x4*)(Cs + li * MLP + d0) = w;
            Vt[(d0 + 0) * MLP + li] = (bf16_t)(zv.x & 0xffffu); Vt[(d0 + 1) * MLP + li] = (bf16_t)(zv.x >> 16); Vt[(d0 + 2) * MLP + li] = (bf16_t)(zv.y & 0xffffu); Vt[(d0 + 3) * MLP + li] = (bf16_t)(zv.y >> 16);
            Vt[(d0 + 4) * MLP + li] = (bf16_t)(zv.z & 0xffffu); Vt[(d0 + 5) * MLP + li] = (bf16_t)(zv.z >> 16); Vt[(d0 + 6) * MLP + li] = (bf16_t)(zv.w & 0xffffu); Vt[(d0 + 7) * MLP + li] = (bf16_t)(zv.w >> 16);
        }
        if (tid >= 448) npL[tid - 448] = NL[(size_t)(bh * 256 + ck) * 64 + tid - 448];
        if (wid == 2) {
            const size_t row = (size_t)b * SEQ + t0 + lane;
            const float ig = G[row * 32 + hd] + bias[hd], lf = log_sigmoid(G[row * 32 + 4 + hd] + bias[4 + hd]);
            const float bs = wave_incl_scan(lf, lane), u = ig - bs, pm = wave_incl_scanmax(u, lane), mprev = MP[bh * 256 + ck];
            const float mt = bs + fmaxf(mprev, pm);
            bL[lane] = bs; uL[lane] = u; mtL[lane] = mt; siL[lane] = __expf(bs + mprev - mt);
        }
        __syncthreads();
        if (wid < 2) {
            const int tl = 32 * wid + r;
            const size_t row = (size_t)b * SEQ + t0 + tl;
            bf16x8 qf[4], ql[4];
#pragma unroll
            for (int ks = 0; ks < 4; ++ks) { qf[ks] = *(const LAS bf16x8*)(Qs + tl * MLP + 16 * ks + 8 * h); ql[ks] = *(const LAS bf16x8*)(Ql + tl * MLP + 16 * ks + 8 * h); }
            const float bt = bL[tl] - mtL[tl], si = siL[tl];
            f32x16 n0, n1; float den = 0.f;
#pragma unroll
            for (int i = 0; i < 16; ++i) { n0[i] = 0.f; n1[i] = 0.f; }
#pragma unroll
            for (int sj = 0; sj < 2; ++sj) {
                if (sj > wid) continue;
                f32x16 sc;
#pragma unroll
                for (int i = 0; i < 16; ++i) sc[i] = 0.f;
#pragma unroll
                for (int ks = 0; ks < 4; ++ks) { const bf16x8 ak = *(const LAS bf16x8*)(Ks + (32 * sj + r) * MLP + 16 * ks + 8 * h), al = *(const LAS bf16x8*)(Kl + (32 * sj + r) * MLP + 16 * ks + 8 * h);
                    sc = __builtin_amdgcn_mfma_f32_32x32x16_bf16(al, qf[ks], sc, 0, 0, 0); sc = __builtin_amdgcn_mfma_f32_32x32x16_bf16(ak, ql[ks], sc, 0, 0, 0); sc = __builtin_amdgcn_mfma_f32_32x32x16_bf16(ak, qf[ks], sc, 0, 0, 0); }
                float wv[16];
#pragma unroll
                for (int i = 0; i < 16; ++i) { const int sidx = 32 * sj + rowi32(i, h); wv[i] = (sidx <= tl) ? __expf(bt + uL[sidx]) * sc[i] : 0.f; den += wv[i]; }
#pragma unroll
                for (int s2 = 0; s2 < 2; ++s2) {
                    const bf16x8 pb = pack8(wv[8 * s2 + 0], wv[8 * s2 + 1], wv[8 * s2 + 2], wv[8 * s2 + 3], wv[8 * s2 + 4], wv[8 * s2 + 5], wv[8 * s2 + 6], wv[8 * s2 + 7]);
                    const LAS bf16_t* vp = Vt + r * MLP + 32 * sj + 16 * s2 + 4 * h;
                    const u32x2 a0l = *(const LAS u32x2*)vp, a0h = *(const LAS u32x2*)(vp + 8);
                    const u32x2 a1l = *(const LAS u32x2*)(vp + 32 * MLP), a1h = *(const LAS u32x2*)(vp + 32 * MLP + 8);
                    const u32x4 v0 = {a0l.x, a0l.y, a0h.x, a0h.y}, v1 = {a1l.x, a1l.y, a1h.x, a1h.y};
                    n0 = __builtin_amdgcn_mfma_f32_32x32x16_bf16(__builtin_bit_cast(bf16x8, v0), pb, n0, 0, 0, 0);
                    n1 = __builtin_amdgcn_mfma_f32_32x32x16_bf16(__builtin_bit_cast(bf16x8, v1), pb, n1, 0, 0, 0);
                }
            }
            f32x16 c0, c1;
#pragma unroll
            for (int i = 0; i < 16; ++i) { c0[i] = 0.f; c1[i] = 0.f; }
#pragma unroll
            for (int ks = 0; ks < 4; ++ks) { const bf16x8 a0 = *(const LAS bf16x8*)(Cs + r * MLP + 16 * ks + 8 * h), a1 = *(const LAS bf16x8*)(Cs + (32 + r) * MLP + 16 * ks + 8 * h);
                c0 = __builtin_amdgcn_mfma_f32_32x32x16_bf16(a0, qf[ks], c0, 0, 0, 0); c1 = __builtin_amdgcn_mfma_f32_32x32x16_bf16(a1, qf[ks], c1, 0, 0, 0); }
            float nq = 0.f;
#pragma unroll
            for (int ks = 0; ks < 4; ++ks) { float qv[8], qw[8]; unpack8(__builtin_bit_cast(u32x4, qf[ks]), qv); unpack8(__builtin_bit_cast(u32x4, ql[ks]), qw);
#pragma unroll
                for (int j = 0; j < 8; ++j) nq += npL[16 * ks + 8 * h + j] * (qv[j] + qw[j]); }
            den += __shfl_xor(den, 32); nq += __shfl_xor(nq, 32);
            den += si * nq;
            const float inv = 1.f / fmaxf(fabsf(den), __expf(-mtL[tl]));
            float ss = 0.f;
#pragma unroll
            for (int g4 = 0; g4 < 4; ++g4) { const int dv = 8 * g4 + 4 * h;
                const u32x2 oa = *(const u32x2*)(Z + row * ZLD + C_MLO + hd * 64 + dv), ob = *(const u32x2*)(Z + row * ZLD + C_MLO + hd * 64 + 32 + dv);
                const float ga[4] = {__uint_as_float(oa.x << 16), __uint_as_float(oa.x & 0xffff0000u), __uint_as_float(oa.y << 16), __uint_as_float(oa.y & 0xffff0000u)};
                const float gb[4] = {__uint_as_float(ob.x << 16), __uint_as_float(ob.x & 0xffff0000u), __uint_as_float(ob.y << 16), __uint_as_float(ob.y & 0xffff0000u)};
#pragma unroll
                for (int e = 0; e < 4; ++e) { const int i = 4 * g4 + e;
                    n0[i] = sigmoidf_(ga[e]) * (n0[i] + si * c0[i]) * inv; n1[i] = sigmoidf_(gb[e]) * (n1[i] + si * c1[i]) * inv; ss += n0[i] * n0[i] + n1[i] * n1[i]; } }
            ss += __shfl_xor(ss, 32);
            const float rn = rsqrtf(ss * (1.f / 64.f) + EPSN);
            bf16_t* orow = Mixed + row * DM + hd * 64;
#pragma unroll
            for (int g4 = 0; g4 < 4; ++g4) { const int dv = 8 * g4 + 4 * h; const f32x4 ga = *(const f32x4*)(gain + hd * 64 + dv), gb = *(const f32x4*)(gain + hd * 64 + 32 + dv);
                u32x2 wa, wb;
                wa.x = pk2(n0[4 * g4 + 0] * rn * ga.x, n0[4 * g4 + 1] * rn * ga.y); wa.y = pk2(n0[4 * g4 + 2] * rn * ga.z, n0[4 * g4 + 3] * rn * ga.w);
                wb.x = pk2(n1[4 * g4 + 0] * rn * gb.x, n1[4 * g4 + 1] * rn * gb.y); wb.y = pk2(n1[4 * g4 + 2] * rn * gb.z, n1[4 * g4 + 3] * rn * gb.w);
                *(u32x2*)(orow + dv) = wa; *(u32x2*)(orow + 32 + dv) = wb; }
        }
    }
}

#define GAS __attribute__((address_space(1)))
#define XB_TMO      128
#define XB_XCNT(j)  (256  + 64 * (j))
#define XB_XSUB(j)  (1280 + 64 * (j))
#define XB_XGEN(j)  (2304 + 64 * (j))
#define XB_TOP      3328
#define XB_TOPGEN   3392
#define XCD_BAR_WORDS 3456
#define XB_SPIN_CAP (1u << 18)

__device__ __forceinline__ unsigned xb_ld(unsigned* p)              { return __hip_atomic_load(p, __ATOMIC_RELAXED, __HIP_MEMORY_SCOPE_AGENT); }
__device__ __forceinline__ unsigned xb_add(unsigned* p, unsigned v) { return __hip_atomic_fetch_add(p, v, __ATOMIC_RELAXED, __HIP_MEMORY_SCOPE_AGENT); }
__device__ __forceinline__ unsigned xb_xcc_id() { return (unsigned)__builtin_amdgcn_s_getreg((3 << 11) | 20) & 0xFu; }
#define XB_SPIN(cond, bar) do { unsigned _sp = 0; while (cond) { __builtin_amdgcn_s_sleep(1); \
    if ((++_sp & 255u) == 0u) { if (xb_ld(&(bar)[XB_TMO])) break; if (_sp > XB_SPIN_CAP) { atomicAdd(&(bar)[XB_TMO], 1u); break; } } } } while (0)

struct XcdBarrier {
    unsigned* bar; unsigned x;
    volatile LAS unsigned* st;
};

__device__ __forceinline__ XcdBarrier xcd_barrier_post(unsigned* bar, volatile LAS unsigned* st) {
    XcdBarrier b; b.bar = bar; b.x = xb_xcc_id(); b.st = st;
    if (threadIdx.x == 0) (void)xb_add(&bar[XB_XCNT(b.x)], 1u);
    return b;
}
__device__ __forceinline__ void xcd_barrier_complete(unsigned* bar, unsigned x, unsigned& nloc, unsigned& nx) {
    const unsigned G = gridDim.x * gridDim.y * gridDim.z;
    unsigned sum, cnt, mine, sp = 0u;
    for (;;) {
        sum = 0u; cnt = 0u; mine = 0u;
#pragma unroll
        for (unsigned j = 0; j < 16; ++j) { const unsigned c = xb_ld(&bar[XB_XCNT(j)]); sum += c; cnt += (c > 0u) ? 1u : 0u; mine = (j == x) ? c : mine; }
        if (sum == G) break;
        __builtin_amdgcn_s_sleep(1);
        if ((++sp & 255u) == 0u) { if (xb_ld(&bar[XB_TMO])) break; if (sp > XB_SPIN_CAP) { atomicAdd(&bar[XB_TMO], 1u); break; } }
    }
    nloc = mine > 0u ? mine : 1u; nx = cnt > 0u ? cnt : 1u;
}

__device__ __forceinline__ void xcd_barrier(const XcdBarrier& b) {
    asm volatile("s_waitcnt vmcnt(0)" ::: "memory");
    __syncthreads();
    if (threadIdx.x == 0) {
        unsigned* bar = b.bar;
        __builtin_amdgcn_s_waitcnt(0);
        unsigned nloc = b.st[0], nx = b.st[1];
        if (nloc == 0u) { xcd_barrier_complete(bar, b.x, nloc, nx); b.st[0] = nloc; b.st[1] = nx; }
        const unsigned old = xb_add(&bar[XB_XSUB(b.x)], 1u);
        const unsigned gen = old / nloc;
        if (old + 1u == (gen + 1u) * nloc) {
            __builtin_amdgcn_fence(__ATOMIC_RELEASE, "agent");
            asm volatile("s_waitcnt vmcnt(0)" ::: "memory");
            const unsigned og = xb_add(&bar[XB_TOP], 1u);
            const unsigned tg = og / nx;
            if (og + 1u == (tg + 1u) * nx) xb_add(&bar[XB_TOPGEN], 1u);
            else XB_SPIN(xb_ld(&bar[XB_TOPGEN]) == tg, bar);
            __builtin_amdgcn_fence(__ATOMIC_ACQUIRE, "agent");
            xb_add(&bar[XB_XGEN(b.x)], 1u);
            asm volatile("s_waitcnt vmcnt(0)" ::: "memory");
        } else {
            XB_SPIN(xb_ld(&bar[XB_XGEN(b.x)]) == gen, bar);
            __builtin_amdgcn_fence(__ATOMIC_ACQUIRE, "agent");
            asm volatile("s_waitcnt vmcnt(0)" ::: "memory");
        }
    }
    __syncthreads();
}

constexpr int LDS_BYTES = 147456;
constexpr int N_PHASES = 19;
typedef const __attribute__((address_space(4))) Params* KArgP;
__device__ __forceinline__ Params load_params(KArgP q) { Params P; P.x = q->x; P.norm1 = q->norm1; P.w_in = q->w_in; P.ml_conv = q->ml_conv; P.ml_gate_bias = q->ml_gate_bias; P.ml_norm = q->ml_norm;
    P.da_lambda = q->da_lambda; P.da_norm = q->da_norm; P.nsa_pe = q->nsa_pe; P.nsa_w1 = q->nsa_w1; P.nsa_w2 = q->nsa_w2; P.w_out = q->w_out; P.norm2 = q->norm2; P.w_ff1 = q->w_ff1; P.w_ff2 = q->w_ff2;
    P.final_norm = q->final_norm; P.out = q->out; P.ws = q->ws; P.ph_lo = q->ph_lo; P.ph_hi = q->ph_hi; P.coop = q->coop; P.pad = q->pad;
    int b_ = blockIdx.x, g_ = gridDim.x; asm volatile("" : "+s"(b_), "+s"(g_)); P.bid = b_; P.gdim = g_; return P; }
#define PHASE_ARGS KArgP q_ = kargs; asm volatile("" : "+s"(q_)); const Params P = load_params(q_); unsigned char* const ws = P.ws; (void)ws; int tid = tid0; asm volatile("" : "+v"(tid)); const int wid = __builtin_amdgcn_readfirstlane(tid >> 6), lane = tid & 63; (void)wid; (void)lane;
__global__ void __launch_bounds__(512, 2) hybrid_fwd(Params p_unused) {
    extern __shared__ __attribute__((aligned(16))) unsigned char lds_raw[];
    LAS unsigned char* lds = (LAS unsigned char*)lds_raw;
    cg::grid_group grid = cg::this_grid();
    const int tid0 = threadIdx.x;
    KArgP kargs = (KArgP)__builtin_amdgcn_kernarg_segment_ptr();
    const int ph_lo = kargs->ph_lo, ph_hi = kargs->ph_hi, coop = kargs->coop;
    volatile LAS unsigned* bar_st = (volatile LAS unsigned*)(lds + LDS_BYTES - 64);
    if (tid0 < 2) bar_st[tid0] = 0u;
    __syncthreads();
    XcdBarrier xbar; xbar.bar = nullptr; xbar.x = 0; xbar.st = bar_st;
    if (coop) xbar = xcd_barrier_post((unsigned*)(kargs->ws + WS_BAR), bar_st);
#define RUN(k) (ph_lo <= (k) && (k) < ph_hi)
#define SEAM(k) do { if (coop && (k) + 1 < ph_hi) { for (int rs_ = 0; rs_ < REP_SYNC; ++rs_) { if ((k) == 0) grid.sync(); else xcd_barrier(xbar); } } } while (0)
    if (RUN(0)) { for (int rep_ = 0; rep_ < REP_PRO; ++rep_) { __syncthreads(); PHASE_ARGS phase_prologue(P, lds, tid, wid, lane); } SEAM(0); }
#pragma unroll 1
    for (int layer = 0; layer < 2; ++layer) {
        const int pb = 1 + 9 * layer;
        if (RUN(pb + 0)) {
            { PHASE_ARGS
            pg8::Gemm g{(const bf16_t*)(ws + WS_HM), (const bf16_t*)(ws + WS_WIN) + (size_t)layer * ZLD * DM, NT, ZLD, DM}; pg8::StaticOrder S; S.init(NT, ZLD, P.gdim, P.bid);
            EpiIn E{(bf16_t*)(ws + WS_ZU), (float*)(ws + WS_G), layer == 0 ? (const float*)nullptr : (const float*)(ws + WS_SS2)};
            for (int rep_ = 0; rep_ < REP_GEMM; ++rep_) pg8::gemm_phase<EpiIn, pg8::StaticOrder, true, true>(lds, g, S, E); }
            SEAM(pb + 0);
        }
        if (RUN(pb + 1)) {
            for (int rep_ = 0; rep_ < REP_MLL; ++rep_) { __syncthreads(); PHASE_ARGS phase_ml_local(P, layer, lds, (const bf16_t*)(ws + WS_ZU), (const float*)(ws + WS_G), (float*)(ws + WS_CL), (float*)(ws + WS_NL), (float*)(ws + WS_GA), tid, wid, lane); }
            __syncthreads();
            for (int rep_ = 0; rep_ < REP_CMPRS; ++rep_) { __syncthreads(); PHASE_ARGS phase_compress(P, layer, lds, (const bf16_t*)(ws + WS_ZU), (bf16_t*)(ws + WS_KC), tid, wid, lane); }
            __syncthreads();
            for (int rep_ = 0; rep_ < REP_VST; ++rep_) { __syncthreads(); PHASE_ARGS phase_vst(P, lds, (const bf16_t*)(ws + WS_ZU), ws + WS_VST, ws + WS_VST + 4 * MiB, tid); }
            __syncthreads();
            for (int rep_ = 0; rep_ < REP_DA; ++rep_) { __syncthreads(); PHASE_ARGS phase_da(P, layer, lds, (const bf16_t*)(ws + WS_ZU), (bf16_t*)(ws + WS_HM), tid, wid, lane); }
            __syncthreads();
            for (int rep_ = 0; rep_ < REP_WIN; ++rep_) { __syncthreads(); PHASE_ARGS phase_win(P, lds, (const bf16_t*)(ws + WS_ZU), (const float*)(ws + WS_G), (bf16_t*)(ws + WS_ACCW), tid, wid, lane); }
            SEAM(pb + 1);
        }
        if (RUN(pb + 2)) {
            { PHASE_ARGS phase_cmp(P, lds, (const bf16_t*)(ws + WS_ZU), (const float*)(ws + WS_G), (const bf16_t*)(ws + WS_KC), (const bf16_t*)(ws + WS_ACCW), (float*)(ws + WS_ACC), (int*)(ws + WS_IDX),
                                   (float*)(ws + WS_CL), (float*)(ws + WS_NL), (const float*)(ws + WS_GA), (float*)(ws + WS_MP), (unsigned*)(ws + WS_QCTR) + 64 * layer, tid, wid, lane); }
            SEAM(pb + 2);
        }
        if (RUN(pb + 3)) {
            for (int rep_ = 0; rep_ < REP_MLO; ++rep_) { __syncthreads(); PHASE_ARGS phase_ml_out(P, layer, lds, (const bf16_t*)(ws + WS_ZU), (const float*)(ws + WS_G), (const float*)(ws + WS_CL), (const float*)(ws + WS_NL), (const float*)(ws + WS_MP), (bf16_t*)(ws + WS_HM), tid, wid, lane); }
            __syncthreads();
            for (int rep_ = 0; rep_ < REP_SEL; ++rep_) { __syncthreads(); PHASE_ARGS phase_sel(P, lds, (const bf16_t*)(ws + WS_ZU), (const float*)(ws + WS_G), ws + WS_VST, ws + WS_VST + 4 * MiB, (const float*)(ws + WS_ACC), (const int*)(ws + WS_IDX), (bf16_t*)(ws + WS_HM), tid, wid, lane); }
            SEAM(pb + 3);
        }
        if (RUN(pb + 4)) {
            { PHASE_ARGS
            pg8::Gemm g{(const bf16_t*)(ws + WS_HM), (const bf16_t*)(ws + WS_WOUT) + (size_t)layer * DM * DM, NT, DM, DM}; pg8::StaticOrder S; S.init(NT, DM, P.gdim, P.bid);
            EpiRes E{layer == 0 ? P.x : P.out, P.out, P.norm2 + layer * DM, (bf16_t*)(ws + WS_ACC), (float*)(ws + WS_SS1)};
            pg8::gemm_phase<EpiRes, pg8::StaticOrder, true, true>(lds, g, S, E); }
            SEAM(pb + 4);
        }
        if (RUN(pb + 6)) {
            { PHASE_ARGS
            pg8::Gemm g{(const bf16_t*)(ws + WS_ACC), (const bf16_t*)(ws + WS_WF1) + (size_t)layer * DM * DFF, NT, DFF, DM}; pg8::StaticOrder S; S.init(NT, DFF, P.gdim, P.bid);
            EpiRelu2 E{(bf16_t*)(ws + WS_ZU), (const float*)(ws + WS_SS1)};
            for (int rep_ = 0; rep_ < REP_GEMM; ++rep_) pg8::gemm_phase<EpiRelu2, pg8::StaticOrder, true, true>(lds, g, S, E); }
            SEAM(pb + 6);
        }
        if (RUN(pb + 7)) {
            { PHASE_ARGS
            pg8::Gemm g{(const bf16_t*)(ws + WS_ZU), (const bf16_t*)(ws + WS_WF2) + (size_t)layer * DM * DFF, NT, DM, DFF}; pg8::StaticOrder S; S.init(NT, DM, P.gdim, P.bid);
            EpiRes E{P.out, P.out, P.norm1 + DM, layer == 0 ? (bf16_t*)(ws + WS_HM) : (bf16_t*)nullptr, (float*)(ws + WS_SS2)};
            pg8::gemm_phase<EpiRes, pg8::StaticOrder, true, true>(lds, g, S, E); }
            SEAM(pb + 7);
        }
        if (RUN(pb + 8) && layer == 1) {
            { PHASE_ARGS
            for (int m = P.bid * 8 + wid; m < NT; m += P.gdim * 8) rms_row_f32(P.out + (size_t)m * DM, P.final_norm, lane); }
        }
    }
}

#ifndef N_LAUNCH_MODE
#define N_LAUNCH_MODE 1
#endif
extern "C" void kernel_launch(void* const* d_in, const int* in_sizes, int n_in, void* d_out, int out_size, void* d_ws, size_t ws_size, hipStream_t stream) {
    static int grid = 0;
    if (grid == 0) {
        int dev = 0, cus = 0, per_cu = 0;
        if (hipGetDevice(&dev) != hipSuccess || hipDeviceGetAttribute(&cus, hipDeviceAttributeMultiprocessorCount, dev) != hipSuccess) { fprintf(stderr, "kernel_launch: device query failed\n"); grid = -1; return; }
        if (hipFuncSetAttribute((const void*)hybrid_fwd, hipFuncAttributeMaxDynamicSharedMemorySize, LDS_BYTES) != hipSuccess) { fprintf(stderr, "kernel_launch: hipFuncSetAttribute failed\n"); grid = -1; return; }
        if (hipOccupancyMaxActiveBlocksPerMultiprocessor(&per_cu, (const void*)hybrid_fwd, 512, LDS_BYTES) != hipSuccess || per_cu < 1) { fprintf(stderr, "kernel_launch: occupancy query says %d\n", per_cu); per_cu = 1; }
        (void)hipGetLastError();
        grid = cus * 1;
        if (n_in != 16 || ws_size < WS_END) { fprintf(stderr, "kernel_launch: unexpected n_in %d / ws_size %zu\n", n_in, ws_size); }
    }
    if (grid < 0) return;
    Params p{};
    p.x = (const float*)d_in[0]; p.norm1 = (const float*)d_in[1]; p.w_in = (const float*)d_in[2]; p.ml_conv = (const float*)d_in[3]; p.ml_gate_bias = (const float*)d_in[4];
    p.ml_norm = (const float*)d_in[5]; p.da_lambda = (const float*)d_in[6]; p.da_norm = (const float*)d_in[7]; p.nsa_pe = (const float*)d_in[8]; p.nsa_w1 = (const float*)d_in[9];
    p.nsa_w2 = (const float*)d_in[10]; p.w_out = (const float*)d_in[11]; p.norm2 = (const float*)d_in[12]; p.w_ff1 = (const float*)d_in[13]; p.w_ff2 = (const float*)d_in[14];
    p.final_norm = (const float*)d_in[15]; p.out = (float*)d_out; p.ws = (unsigned char*)d_ws;
#if N_LAUNCH_MODE == 1
    if (hipMemsetAsync((char*)d_ws + WS_BAR, 0, 16384, stream) != hipSuccess) { fprintf(stderr, "kernel_launch: hipMemsetAsync of the barrier words failed\n"); return; }
    p.ph_lo = 0; p.ph_hi = N_PHASES; p.coop = 1; p.pad = 0; p.bid = 0; p.gdim = 0;
    void* args[] = {&p};
    hipError_t e = hipLaunchCooperativeKernel((const void*)hybrid_fwd, dim3(grid), dim3(512), args, LDS_BYTES, stream);
    if (e != hipSuccess) fprintf(stderr, "cooperative launch failed: %s (grid %d)\n", hipGetErrorString(e), grid);
#else
    for (int k = 0; k < N_PHASES; ++k) {
        p.ph_lo = k; p.ph_hi = k + 1; p.coop = 0; p.pad = 0; p.bid = 0; p.gdim = 0;
        hipLaunchKernelGGL(hybrid_fwd, dim3(grid), dim3(512), LDS_BYTES, stream, p);
    }
#endif
}
```
